# Optimizing an MI355X kernel written in HIP

```python
import jax, jax.numpy as jnp
from jax import lax
import numpy as np

D_MODEL = 1024
BATCH = 4
SEQ = 8192
DEPTH = 4

WINDOWS = (128, 512, 2048)
DILATIONS = (1, 4, 16)
N_GROUPS = 3
HEADS_PER_GROUP = 8
HEAD_DIM = 128
N_ATTN_HEADS = N_GROUPS * HEADS_PER_GROUP
ATTN_OUT_WIDTH = HEADS_PER_GROUP * HEAD_DIM
QKV_WIDTH = N_GROUPS * 3 * HEADS_PER_GROUP * HEAD_DIM
NUM_BUCKETS = 32
MAX_DISTANCE = 2048
LRU_WIDTH = D_MODEL
LRU_BLOCKS = 4
LRU_BLOCK_WIDTH = LRU_WIDTH // LRU_BLOCKS
LRU_CONV_WIDTH = 4
LRU_C = 8.0
D_FF = 3 * D_MODEL
FFN_CONV_WIDTH = 3

RMS_EPS = 1e-6
NEG_INF = -1e30
N_ATTN_LAYERS = (DEPTH + 1) // 2
N_LRU_LAYERS = DEPTH // 2

kernel_name = "hybrid_dilated_attn_rglru_convffn"


def rms_norm(x, g):
    xf = x.astype(jnp.float32)
    y = xf * lax.rsqrt(jnp.mean(xf * xf, axis=-1, keepdims=True) + RMS_EPS)
    return (y * g.astype(jnp.float32)).astype(x.dtype)


def causal_dwconv(x, w, b):
    K = w.shape[0]
    S = x.shape[1]
    xp = jnp.pad(x, ((0, 0), (K - 1, 0), (0, 0)))
    out = b
    for k in range(K):
        out = out + xp[:, k:k + S] * w[k]
    return out


def t5_bucket(dist):
    max_exact = NUM_BUCKETS // 2
    d = np.maximum(dist, 1).astype(np.float64)
    large = max_exact + (np.log(d / max_exact) / np.log(MAX_DISTANCE / max_exact)
                         * (NUM_BUCKETS - max_exact)).astype(np.int32)
    large = np.minimum(large, NUM_BUCKETS - 1)
    return np.where(dist < max_exact, dist, large).astype(np.int32)


def band_geometry(band):
    i = np.arange(band)[:, None]
    k = np.arange(2 * band)[None, :]
    m = i + band - k
    valid = (m >= 0) & (m <= band)
    return m, valid, k


def dilated_group_attention(q, k, v, bias_table, window, dilation):
    B, S, H, Dh = q.shape
    band = window // dilation
    span = dilation * band
    S_pad = -(-S // span) * span
    U = S_pad // dilation
    nb = U // band

    def to_strided(t):
        t = jnp.pad(t, ((0, 0), (0, S_pad - S), (0, 0), (0, 0)))
        t = t.reshape(B, U, dilation, H, Dh).transpose(0, 2, 3, 1, 4)
        return t.reshape(B, dilation, H, nb, band, Dh)

    qs, ks, vs = to_strided(q), to_strided(k), to_strided(v)
    pad_blk = ((0, 0), (0, 0), (0, 0), (1, 0), (0, 0), (0, 0))
    kk = jnp.concatenate([jnp.pad(ks, pad_blk)[:, :, :, :-1], ks], axis=-2)
    vv = jnp.concatenate([jnp.pad(vs, pad_blk)[:, :, :, :-1], vs], axis=-2)

    m, valid, kidx = band_geometry(band)
    bucket = t5_bucket(np.clip(m, 0, band) * dilation)
    bias = jnp.transpose(bias_table.astype(jnp.float32)[bucket], (2, 0, 1))
    blk = np.arange(nb)[:, None, None]
    mask = valid[None] & ((blk > 0) | (kidx[None] >= band))

    scale = HEAD_DIM ** -0.5
    logits = jnp.einsum('bxhnqd,bxhnkd->bxhnqk', qs, kk,
                        preferred_element_type=jnp.float32) * scale
    logits = logits + bias[None, None, :, None]
    logits = jnp.where(mask[None, None, None], logits, NEG_INF)
    mx = jnp.max(logits, axis=-1, keepdims=True)
    p = jnp.exp(logits - mx)
    s = jnp.sum(p, axis=-1, keepdims=True)
    o = jnp.einsum('bxhnqk,bxhnkd->bxhnqd', p, vv.astype(jnp.float32)) / s
    lse = (mx + jnp.log(s))[..., 0]

    o = o.reshape(B, dilation, H, U, Dh).transpose(0, 3, 1, 2, 4).reshape(B, S_pad, H, Dh)[:, :S]
    lse = lse.reshape(B, dilation, H, U).transpose(0, 3, 1, 2).reshape(B, S_pad, H)[:, :S]
    return o, lse


def dilated_attention_mixer(x, w_qkv, w_o, rel_bias):
    B, S, _ = x.shape
    qkv = (x @ w_qkv).reshape(B, S, N_GROUPS, 3, HEADS_PER_GROUP, HEAD_DIM)
    outs, lses = [], []
    for g in range(N_GROUPS):
        tbl = rel_bias[:, g * HEADS_PER_GROUP:(g + 1) * HEADS_PER_GROUP]
        o, lse = dilated_group_attention(qkv[:, :, g, 0], qkv[:, :, g, 1], qkv[:, :, g, 2],
                                         tbl, WINDOWS[g], DILATIONS[g])
        outs.append(o)
        lses.append(lse)
    alpha = jax.nn.softmax(jnp.stack(lses), axis=0)
    o = jnp.sum(alpha[..., None] * jnp.stack(outs), axis=0)
    return o.reshape(B, S, ATTN_OUT_WIDTH).astype(x.dtype) @ w_o


def _lru_combine(c1, c2):
    a1, b1 = c1
    a2, b2 = c2
    return a1 * a2, a2 * b1 + b2


def rglru_mixer(x, w_in, conv_w, conv_b, ga_w, ga_b, gx_w, gx_b, lam, w_out):
    B, S, _ = x.shape
    h = x @ w_in
    xb, gb = h[..., :LRU_WIDTH], h[..., LRU_WIDTH:]
    gate = jax.nn.gelu(gb, approximate=True)
    xb = causal_dwconv(xb, conv_w, conv_b)
    xr = xb.reshape(B, S, LRU_BLOCKS, LRU_BLOCK_WIDTH)
    r = jax.nn.sigmoid(jnp.einsum('bsnc,ncd->bsnd', xr, ga_w) + ga_b).reshape(B, S, LRU_WIDTH)
    i = jax.nn.sigmoid(jnp.einsum('bsnc,ncd->bsnd', xr, gx_w) + gx_b).reshape(B, S, LRU_WIDTH)
    log_a = LRU_C * r.astype(jnp.float32) * jax.nn.log_sigmoid(lam.astype(jnp.float32))
    a = jnp.exp(log_a)
    mult = jnp.sqrt(jnp.maximum(-jnp.expm1(2.0 * log_a), 0.0))
    b = mult * i.astype(jnp.float32) * xb.astype(jnp.float32)
    _, hs = lax.associative_scan(_lru_combine, (a, b), axis=1)
    return (hs.astype(x.dtype) * gate) @ w_out


def conv_ffn(x, w_up, conv_w, conv_b, w_down):
    u = causal_dwconv(x @ w_up, conv_w, conv_b)
    g, v = u[..., :D_FF], u[..., D_FF:]
    return (jax.nn.gelu(g, approximate=True) * v) @ w_down


def setup_inputs(seed: int = 0) -> dict:
    key = jax.random.key(seed)
    ks = jax.random.split(key, 32)
    f32 = jnp.float32
    nrm = lambda k, shape, s: jax.random.normal(k, shape, f32) * s
    gain = lambda k: 1.0 + 0.05 * jax.random.normal(k, (DEPTH, D_MODEL), f32)
    a_target = jax.random.uniform(ks[20], (N_LRU_LAYERS, LRU_WIDTH), f32, 0.9, 0.999)
    p = a_target ** (1.0 / LRU_C)
    lam = jnp.log(p) - jnp.log1p(-p)
    return {
        "x": nrm(ks[0], (BATCH, SEQ, D_MODEL), 1.0),
        "norm_mix_pre": gain(ks[1]),
        "norm_mix_post": gain(ks[2]),
        "norm_ffn_pre": gain(ks[3]),
        "norm_ffn_post": gain(ks[4]),
        "rel_bias": nrm(ks[5], (NUM_BUCKETS, N_ATTN_HEADS), 0.5),
        "attn_w_qkv": nrm(ks[6], (N_ATTN_LAYERS, D_MODEL, QKV_WIDTH), D_MODEL ** -0.5),
        "attn_w_o": nrm(ks[7], (N_ATTN_LAYERS, ATTN_OUT_WIDTH, D_MODEL), ATTN_OUT_WIDTH ** -0.5),
        "lru_w_in": nrm(ks[8], (N_LRU_LAYERS, D_MODEL, 2 * LRU_WIDTH), D_MODEL ** -0.5),
        "lru_conv_w": nrm(ks[9], (N_LRU_LAYERS, LRU_CONV_WIDTH, LRU_WIDTH), LRU_CONV_WIDTH ** -0.5),
        "lru_conv_b": nrm(ks[10], (N_LRU_LAYERS, LRU_WIDTH), 0.02),
        "lru_ga_w": nrm(ks[11], (N_LRU_LAYERS, LRU_BLOCKS, LRU_BLOCK_WIDTH, LRU_BLOCK_WIDTH), LRU_BLOCK_WIDTH ** -0.5),
        "lru_ga_b": nrm(ks[12], (N_LRU_LAYERS, LRU_BLOCKS, LRU_BLOCK_WIDTH), 0.02),
        "lru_gx_w": nrm(ks[13], (N_LRU_LAYERS, LRU_BLOCKS, LRU_BLOCK_WIDTH, LRU_BLOCK_WIDTH), LRU_BLOCK_WIDTH ** -0.5),
        "lru_gx_b": nrm(ks[14], (N_LRU_LAYERS, LRU_BLOCKS, LRU_BLOCK_WIDTH), 0.02),
        "lru_lambda": lam,
        "lru_w_out": nrm(ks[15], (N_LRU_LAYERS, LRU_WIDTH, D_MODEL), LRU_WIDTH ** -0.5),
        "ffn_w_up": nrm(ks[16], (DEPTH, D_MODEL, 2 * D_FF), D_MODEL ** -0.5),
        "ffn_conv_w": nrm(ks[17], (DEPTH, FFN_CONV_WIDTH, 2 * D_FF), FFN_CONV_WIDTH ** -0.5),
        "ffn_conv_b": nrm(ks[18], (DEPTH, 2 * D_FF), 0.02),
        "ffn_w_down": nrm(ks[19], (DEPTH, D_FF, D_MODEL), D_FF ** -0.5),
    }


def reference(x, norm_mix_pre, norm_mix_post, norm_ffn_pre, norm_ffn_post, rel_bias,
              attn_w_qkv, attn_w_o, lru_w_in, lru_conv_w, lru_conv_b, lru_ga_w, lru_ga_b,
              lru_gx_w, lru_gx_b, lru_lambda, lru_w_out, ffn_w_up, ffn_conv_w, ffn_conv_b,
              ffn_w_down):
    for layer in range(DEPTH):
        j = layer // 2
        h = rms_norm(x, norm_mix_pre[layer])
        if layer % 2 == 0:
            h = dilated_attention_mixer(h, attn_w_qkv[j], attn_w_o[j], rel_bias)
        else:
            h = rglru_mixer(h, lru_w_in[j], lru_conv_w[j], lru_conv_b[j], lru_ga_w[j], lru_ga_b[j],
                            lru_gx_w[j], lru_gx_b[j], lru_lambda[j], lru_w_out[j])
        x = x + rms_norm(h, norm_mix_post[layer])
        h = rms_norm(x, norm_ffn_pre[layer])
        h = conv_ffn(h, ffn_w_up[layer], ffn_conv_w[layer], ffn_conv_b[layer], ffn_w_down[layer])
        x = x + rms_norm(h, norm_ffn_post[layer])
    return x
```

```cpp
#include <hip/hip_runtime.h>
#include <hip/hip_cooperative_groups.h>
#include <cstdio>
#include <cmath>
#include <cstring>
namespace cg = cooperative_groups;

#define LAS __attribute__((address_space(3)))
typedef unsigned short bf16_t;
typedef short bf16x8 __attribute__((ext_vector_type(8)));
typedef short bf16x4 __attribute__((ext_vector_type(4)));
typedef float f32x4 __attribute__((ext_vector_type(4)));
typedef unsigned u32x4 __attribute__((ext_vector_type(4)));
typedef unsigned u32x2 __attribute__((ext_vector_type(2)));

constexpr int M_TOK = 32768, DM = 1024, SEQ = 8192;
constexpr float RMS_EPS = 1e-6f;
constexpr float LOG2E = 1.4426950408889634f;

__device__ __forceinline__ unsigned pk2(float lo, float hi) { unsigned r; asm("v_cvt_pk_bf16_f32 %0, %1, %2" : "=v"(r) : "v"(lo), "v"(hi)); return r; }
__device__ __forceinline__ float bflo(unsigned w) { return __uint_as_float(w << 16); }
__device__ __forceinline__ float bfhi(unsigned w) { return __uint_as_float(w & 0xffff0000u); }
__device__ __forceinline__ float gelu_tanh(float x) {
    const float inner = x + 0.044715f * x * x * x;
    const float e = __builtin_amdgcn_exp2f(-2.0f * 0.7978845608028654f * LOG2E * inner);
    return x * __builtin_amdgcn_rcpf(1.0f + e);
}
__device__ __forceinline__ f32x4 gelu_mul4(const f32x4 x, const f32x4 v) {
    constexpr float K0 = -2.0f * 0.7978845608028654f * LOG2E, K1 = K0 * 0.044715f;
    const f32x4 t = ((x * x) * K1 + K0) * x;
    f32x4 e; e[0] = __builtin_amdgcn_exp2f(t[0]); e[1] = __builtin_amdgcn_exp2f(t[1]); e[2] = __builtin_amdgcn_exp2f(t[2]); e[3] = __builtin_amdgcn_exp2f(t[3]);
    const f32x4 d = e + 1.0f;
    f32x4 r; r[0] = __builtin_amdgcn_rcpf(d[0]); r[1] = __builtin_amdgcn_rcpf(d[1]); r[2] = __builtin_amdgcn_rcpf(d[2]); r[3] = __builtin_amdgcn_rcpf(d[3]);
    return (x * v) * r;
}
__device__ __forceinline__ float sigmoidf_(float x) { return __builtin_amdgcn_rcpf(1.0f + __builtin_amdgcn_exp2f(-LOG2E * x)); }
__device__ __forceinline__ float wave_sum(float v) {
#pragma unroll
    for (int o = 1; o < 64; o <<= 1) v += __shfl_xor(v, o);
    return v;
}
__device__ __forceinline__ f32x4 shfl_up4(f32x4 v, int d) { f32x4 r; r[0] = __shfl_up(v[0], d, 16); r[1] = __shfl_up(v[1], d, 16); r[2] = __shfl_up(v[2], d, 16); r[3] = __shfl_up(v[3], d, 16); return r; }

constexpr int BM = 256, BK = 64, HALF = 128, HTB = HALF * BK * 2, STAGE_BYTES = 8 * HTB, NXCD = 8, WGM = 8;
__device__ __forceinline__ int lds_byte(int r, int c) { const int st = (r >> 4) * 2 + (c >> 5), rr = r & 15, cc = c & 31, ob = rr * 64 + cc * 2; return st * 1024 + (ob ^ (((ob >> 9) & 1) << 5)); }
__device__ __forceinline__ void stage_rc(int b, int& R, int& C) { const int st = b / 1024, sb = b % 1024, swz = sb ^ (((sb >> 9) & 1) << 5); R = (st >> 1) * 16 + swz / 64; C = (st & 1) * 32 + (swz % 64) / 2; }
__device__ __forceinline__ int perm32(int rho) { const int n = rho >> 4, i = rho & 15; return 8 * (i >> 2) + 4 * n + (i & 3); }

struct Unit { int pm, pn; };
struct Gemm { const bf16_t* A; const bf16_t* Bt; int lda, ldb, K, nM, nN, mode, stride, spb, ksA, ksB; };
struct StaticOrder {
    int nM, nN, nwg, G, c;
    __device__ void init(int nM_, int nN_, int G_, int c_) { nM = nM_; nN = nN_; nwg = nM * nN; G = G_; c = c_; }
    __device__ bool next(int i, Unit& u) const {
        const long L = (long)i * G + c; if (L >= nwg) return false;
        int wgid = (int)L; { const int q = nwg / NXCD, r = nwg % NXCD, xcd = wgid % NXCD, off = wgid / NXCD; wgid = (xcd < r ? xcd * (q + 1) : r * (q + 1) + (xcd - r) * q) + off; }
        const int nig = WGM * nN, gid = wgid / nig, fm = gid * WGM, gsz = (nM - fm) < WGM ? (nM - fm) : WGM;
        u.pm = fm + ((wgid % nig) % gsz); u.pn = (wgid % nig) / gsz; return true;
    }
};
__device__ __forceinline__ unsigned a_voff(const Gemm& g, const Unit& u, int piece, int R, int C) {
    int row, col = C;
    if (g.mode == 0) row = u.pm * 256 + R;
    else { const int sg = 2 * u.pm + piece, b = sg / g.spb, s = sg - b * g.spb; row = b * SEQ + g.stride * s + (R & 15) * 8 + ((R >> 4) & 3); if (g.mode == 2) col += (u.pn >> 1) * 256; }
    return (unsigned)(row * g.lda + col) * 2u;
}

typedef f32x4 Acc[2][2][4][2];
__device__ __forceinline__ float rstd_from_parts(const f32x4 p) { return 1.0f / sqrtf(((p[0] + p[1]) + (p[2] + p[3])) * (1.0f / 1024.0f) + 1e-6f); }
constexpr int PRM_OFF = 8 * 128 * 64 * 2 + 12288;
constexpr int PRM_STRIDE = 10240;
__device__ __forceinline__ void rstd_to_lds(LAS unsigned char* prm) {
    int t_ = threadIdx.x; asm volatile("" : "+v"(t_));
    if (t_ < 256) ((LAS float*)prm)[2304 + t_] = rstd_from_parts(((const LAS f32x4*)prm)[t_]);
    asm volatile("s_waitcnt lgkmcnt(0)" ::: "memory"); __builtin_amdgcn_s_barrier(); asm volatile("" ::: "memory");
}


template <class Epi>
__device__ __forceinline__ void gemm_phase(LAS unsigned char* lds, const Gemm g, const StaticOrder& S, const Epi& E) {
    int tid_ = threadIdx.x; asm volatile("" : "+v"(tid_));
    const int tid = tid_, wid = __builtin_amdgcn_readfirstlane(tid >> 6), lane = tid & 63, wr = wid >> 2, wc = wid & 3, fr = lane & 15, fq = lane >> 4;
    int K_ = g.K; asm volatile("" : "+s"(K_));
    const int K = K_, nt = K / BK;
    int R0, C0, R1, C1; stage_rc(tid * 16, R0, C0); stage_rc(tid * 16 + 8192, R1, C1);
    unsigned voffB[2];
    { const int Rb0 = (R0 & ~31) + perm32(R0 & 31), Rb1 = (R1 & ~31) + perm32(R1 & 31); voffB[0] = (unsigned)(Rb0 * g.ldb + C0) * 2u; voffB[1] = (unsigned)(Rb1 * g.ldb + C1) * 2u; }
    const size_t kstepA = Epi::RT_KSTEP ? (size_t)g.ksA : (size_t)128, kstepB = Epi::RT_KSTEP ? (size_t)g.ksB : (size_t)128;
    const size_t hstepA = (g.mode == 0) ? (size_t)HALF * g.lda * 2 : (size_t)4 * g.lda * 2;
    const size_t hstepB = (size_t)HALF * g.ldb * 2;
    const size_t tstepB = 2 * hstepB;
    const unsigned ldsw = (unsigned)wid * 1024u;
    const int aoff = lds_byte(wr * 64 + fr, fq * 8), boff = lds_byte(wc * 32 + fr, fq * 8);
#define PG8_SA(b, h) (((b) * 2 + (h)) * HTB)
#define PG8_SB(b, h) ((4 + (b) * 2 + (h)) * HTB)
#define PG8_STG(bufoff, gbase, o0, o1) do { \
        __builtin_amdgcn_global_load_lds((const unsigned*)((const char*)(gbase) + (o0)), (LAS unsigned*)(lds + (bufoff) + ldsw), 16, 0, 0); \
        __builtin_amdgcn_global_load_lds((const unsigned*)((const char*)(gbase) + (o1)), (LAS unsigned*)(lds + (bufoff) + ldsw + 8192), 16, 0, 0); } while (0)
#define PG8_LDA(dst, b, h) do { _Pragma("unroll") for (int m = 0; m < 4; ++m) _Pragma("unroll") for (int k = 0; k < 2; ++k) dst[m][k] = *(const LAS bf16x8*)(lds + PG8_SA(b, h) + aoff + m * 2048 + k * 1024); } while (0)
#define PG8_LDB(dst, b, h) do { _Pragma("unroll") for (int n = 0; n < 2; ++n) _Pragma("unroll") for (int k = 0; k < 2; ++k) dst[n][k] = *(const LAS bf16x8*)(lds + PG8_SB(b, h) + boff + n * 2048 + k * 1024); } while (0)
#define PG8_MMA(ai, bj, At, Bt) do { __builtin_amdgcn_s_setprio(1); _Pragma("unroll") for (int m = 0; m < 4; ++m) _Pragma("unroll") for (int n = 0; n < 2; ++n) _Pragma("unroll") for (int k = 0; k < 2; ++k) \
        acc[ai][bj][m][n] = __builtin_amdgcn_mfma_f32_16x16x32_bf16(Bt[n][k], At[m][k], acc[ai][bj][m][n], 0, 0, 0); __builtin_amdgcn_s_setprio(0); } while (0)
#define PG8_MMAZ(ai, bj, At, Bt) do { __builtin_amdgcn_s_setprio(1); _Pragma("unroll") for (int m = 0; m < 4; ++m) _Pragma("unroll") for (int n = 0; n < 2; ++n) { \
        acc[ai][bj][m][n] = __builtin_amdgcn_mfma_f32_16x16x32_bf16(Bt[n][0], At[m][0], (f32x4){0.f, 0.f, 0.f, 0.f}, 0, 0, 0); \
        acc[ai][bj][m][n] = __builtin_amdgcn_mfma_f32_16x16x32_bf16(Bt[n][1], At[m][1], acc[ai][bj][m][n], 0, 0, 0); } __builtin_amdgcn_s_setprio(0); } while (0)
#define PG8_WAIT_V(n) asm volatile("s_waitcnt vmcnt(" #n ")" ::: "memory")
#define PG8_WAIT_L(n) asm volatile("s_waitcnt lgkmcnt(" #n ")" ::: "memory")
#define PG8_BAR __builtin_amdgcn_s_barrier()
#define PG8_SCHED __builtin_amdgcn_sched_barrier(0)
    Unit cur, nxt; int ui = 0;
    if (!S.next(0, cur)) return;
    Acc acc;
    if constexpr (!Epi::PEEL) {
#pragma unroll
        for (int a = 0; a < 2; ++a)
#pragma unroll
            for (int b = 0; b < 2; ++b)
#pragma unroll
                for (int m = 0; m < 4; ++m)
#pragma unroll
                    for (int n = 0; n < 2; ++n) acc[a][b][m][n] = (f32x4){0.f, 0.f, 0.f, 0.f};
    }
    bf16x8 At[4][2], B0[2][2], B1[2][2];
    const char* const Ab = (const char*)g.A;
    unsigned vA0 = a_voff(g, cur, 0, R0, C0), vA1 = a_voff(g, cur, 1, R1, C1);
    const char* cB = (const char*)g.Bt + (size_t)cur.pn * tstepB;
    PG8_STG(PG8_SB(0, 0), cB, voffB[0], voffB[1]); PG8_STG(PG8_SB(0, 1), cB + hstepB, voffB[0], voffB[1]); PG8_STG(PG8_SA(0, 0), Ab, vA0, vA1); PG8_STG(PG8_SA(0, 1), Ab + hstepA, vA0, vA1);
    if (wr == 1) PG8_BAR;
    PG8_WAIT_V(2); PG8_BAR;
    PG8_STG(PG8_SB(1, 0), cB + kstepB, voffB[0], voffB[1]); PG8_STG(PG8_SA(1, 0), Ab + kstepA, vA0, vA1); PG8_STG(PG8_SB(1, 1), cB + hstepB + kstepB, voffB[0], voffB[1]);
    PG8_WAIT_V(6); PG8_BAR;
    for (;;) {
        const bool has_next = S.next(ui + 1, nxt);
        unsigned vN0 = vA0, vN1 = vA1;
        if (has_next) { int t2 = threadIdx.x; asm volatile("" : "+v"(t2)); int r0, c0, r1, c1; stage_rc(t2 * 16, r0, c0); stage_rc(t2 * 16 + 8192, r1, c1); vN0 = a_voff(g, nxt, 0, r0, c0); vN1 = a_voff(g, nxt, 1, r1, c1); }
        const char* nB = has_next ? (const char*)g.Bt + (size_t)nxt.pn * tstepB : cB;
        E.prefetch(lds + PRM_OFF + (ui & 1) * PRM_STRIDE, cur, wid);
        if constexpr (Epi::PEEL)
        {
            const int t = 0;
            const bool last = false;
            const char* a1 = Ab + (size_t)(t + 1) * kstepA;
            const char* a2 = last ? Ab : Ab + (size_t)(t + 2) * kstepA; const char* b2 = last ? nB : cB + (size_t)(t + 2) * kstepB;
            const char* a3 = a2 + kstepA; const char* b3 = b2 + kstepB;
            const unsigned w0 = last ? vN0 : vA0, w1 = last ? vN1 : vA1;
            PG8_LDB(B0, 0, 0); PG8_LDB(B1, 0, 1); PG8_SCHED; PG8_LDA(At, 0, 0); PG8_STG(PG8_SA(1, 1), a1 + hstepA, vA0, vA1);
            PG8_WAIT_V(8); PG8_WAIT_L(0); PG8_BAR; PG8_MMAZ(0, 0, At, B0); PG8_MMAZ(0, 1, At, B1); PG8_BAR; PG8_SCHED;
            PG8_LDA(At, 0, 1); PG8_STG(PG8_SB(0, 0), b2, voffB[0], voffB[1]); PG8_STG(PG8_SB(0, 1), b2 + hstepB, voffB[0], voffB[1]); PG8_STG(PG8_SA(0, 0), a2, w0, w1);
            PG8_WAIT_V(8); PG8_WAIT_L(0); PG8_BAR; PG8_MMAZ(1, 0, At, B0); PG8_MMAZ(1, 1, At, B1); PG8_BAR; PG8_SCHED;
            PG8_LDB(B0, 1, 0); PG8_LDB(B1, 1, 1); PG8_SCHED; PG8_LDA(At, 1, 0); PG8_STG(PG8_SA(0, 1), a2 + hstepA, w0, w1);
            PG8_WAIT_V(8); PG8_WAIT_L(0); PG8_BAR; PG8_MMA(0, 0, At, B0); PG8_MMA(0, 1, At, B1); PG8_BAR; PG8_SCHED;
            PG8_LDA(At, 1, 1); PG8_STG(PG8_SB(1, 0), b3, voffB[0], voffB[1]); PG8_STG(PG8_SB(1, 1), b3 + hstepB, voffB[0], voffB[1]); PG8_STG(PG8_SA(1, 0), a3, w0, w1);
            PG8_WAIT_V(8); PG8_WAIT_L(0); PG8_BAR; PG8_MMA(1, 0, At, B0); PG8_MMA(1, 1, At, B1); PG8_BAR; PG8_SCHED;
        }
        for (int t = Epi::PEEL ? 2 : 0; t < nt; t += 2) {
            const bool last = (t == nt - 2);
            const char* a1 = Ab + (size_t)(t + 1) * kstepA;
            const char* a2 = last ? Ab : Ab + (size_t)(t + 2) * kstepA; const char* b2 = last ? nB : cB + (size_t)(t + 2) * kstepB;
            const char* a3 = a2 + kstepA; const char* b3 = b2 + kstepB;
            const unsigned w0 = last ? vN0 : vA0, w1 = last ? vN1 : vA1;
            PG8_LDB(B0, 0, 0); PG8_LDB(B1, 0, 1); PG8_SCHED; PG8_LDA(At, 0, 0); PG8_STG(PG8_SA(1, 1), a1 + hstepA, vA0, vA1);
            PG8_WAIT_V(8); PG8_WAIT_L(0); PG8_BAR; PG8_MMA(0, 0, At, B0); PG8_MMA(0, 1, At, B1); PG8_BAR; PG8_SCHED;
            PG8_LDA(At, 0, 1); PG8_STG(PG8_SB(0, 0), b2, voffB[0], voffB[1]); PG8_STG(PG8_SB(0, 1), b2 + hstepB, voffB[0], voffB[1]); PG8_STG(PG8_SA(0, 0), a2, w0, w1);
            PG8_WAIT_V(8); PG8_WAIT_L(0); PG8_BAR; PG8_MMA(1, 0, At, B0); PG8_MMA(1, 1, At, B1); PG8_BAR; PG8_SCHED;
            PG8_LDB(B0, 1, 0); PG8_LDB(B1, 1, 1); PG8_SCHED; PG8_LDA(At, 1, 0); PG8_STG(PG8_SA(0, 1), a2 + hstepA, w0, w1);
            PG8_WAIT_V(8); PG8_WAIT_L(0); PG8_BAR; PG8_MMA(0, 0, At, B0); PG8_MMA(0, 1, At, B1); PG8_BAR; PG8_SCHED;
            PG8_LDA(At, 1, 1); PG8_STG(PG8_SB(1, 0), b3, voffB[0], voffB[1]); PG8_STG(PG8_SB(1, 1), b3 + hstepB, voffB[0], voffB[1]); PG8_STG(PG8_SA(1, 0), a3, w0, w1);
            PG8_WAIT_V(8); PG8_WAIT_L(0); PG8_BAR; PG8_MMA(1, 0, At, B0); PG8_MMA(1, 1, At, B1); PG8_BAR; PG8_SCHED;
        }
        if (wr == 0) PG8_BAR;
        E(acc, cur, wr, wc, fr, fq, lds + PRM_OFF + (ui & 1) * PRM_STRIDE);
        if (!has_next) break;
        if constexpr (!Epi::PEEL) {
#pragma unroll
            for (int a = 0; a < 2; ++a)
#pragma unroll
                for (int b = 0; b < 2; ++b)
#pragma unroll
                    for (int m = 0; m < 4; ++m)
#pragma unroll
                        for (int n = 0; n < 2; ++n) acc[a][b][m][n] = (f32x4){0.f, 0.f, 0.f, 0.f};
        }
        cur = nxt; cB = nB; vA0 = vN0; vA1 = vN1; ++ui;
        if (wr == 1) PG8_BAR;
    }
    PG8_WAIT_V(0);
    PG8_BAR;
#undef PG8_SA
#undef PG8_SB
#undef PG8_STG
#undef PG8_LDA
#undef PG8_LDB
#undef PG8_MMA
#undef PG8_MMAZ
#undef PG8_WAIT_V
#undef PG8_WAIT_L
#undef PG8_BAR
#undef PG8_SCHED
}


__device__ __forceinline__ float row_rstd(const float* P2, int row) {
    const f32x4 p = *(const f32x4*)(P2 + (size_t)row * 4);
    return 1.0f / sqrtf(((p[0] + p[1]) + (p[2] + p[3])) * (1.0f / DM) + RMS_EPS);
}
struct EpiScale {
    static constexpr bool PEEL = true;
    static constexpr bool RT_KSTEP = false;
    bf16_t* O; int ldc; const float* rstd;
    __device__ __forceinline__ void prefetch(LAS unsigned char* prm, const Unit& u, int wid) const {
        if (wid < 4) { int t_ = threadIdx.x; asm volatile("" : "+v"(t_));
            __builtin_amdgcn_global_load_lds((const unsigned*)(rstd + (size_t)(u.pm * 256 + t_) * 4), (LAS unsigned*)(prm + wid * 1024), 16, 0, 0); }
    }
    __device__ __forceinline__ void operator()(Acc& acc, const Unit& u, int wr, int wc, int fr, int fq, LAS unsigned char* prm) const {
        { int t_ = threadIdx.x; asm volatile("" : "+v"(t_)); fr = t_ & 15; fq = (t_ >> 4) & 3; }
        const int row0 = u.pm * 256 + wr * 64 + fr, col0 = u.pn * 256 + wc * 32 + 8 * fq;
        rstd_to_lds(prm);
        float rsv[2][4];
#pragma unroll
        for (int ai = 0; ai < 2; ++ai)
#pragma unroll
            for (int m = 0; m < 4; ++m) rsv[ai][m] = ((const LAS float*)prm)[2304 + wr * 64 + fr + ai * 128 + m * 16];
#pragma unroll
        for (int ai = 0; ai < 2; ++ai)
#pragma unroll
            for (int m = 0; m < 4; ++m) {
                const int row = row0 + ai * 128 + m * 16;
                const float rs = rsv[ai][m];
                bf16_t* rowp = O + ((size_t)(2 * u.pn) * M_TOK + row) * 128 + wc * 32 + 8 * fq;
#pragma unroll
                for (int bj = 0; bj < 2; ++bj) {
                    const f32x4 v0 = acc[ai][bj][m][0] * rs, v1 = acc[ai][bj][m][1] * rs;
                    u32x4 w; w.x = pk2(v0[0], v0[1]); w.y = pk2(v0[2], v0[3]); w.z = pk2(v1[0], v1[1]); w.w = pk2(v1[2], v1[3]);
                    *(u32x4*)(rowp + (size_t)bj * M_TOK * 128) = w;
                }
            }
    }
};

struct EpiUp {
    static constexpr bool PEEL = false;
    static constexpr bool RT_KSTEP = false;
    bf16_t* O; const float* rstd; const float* cw; const float* cb;
    __device__ __forceinline__ void prefetch(LAS unsigned char* prm, const Unit& u, int wid) const {
        int t_ = threadIdx.x; asm volatile("" : "+v"(t_));
        if (wid < 4) { const int sg = 2 * u.pm + (t_ >> 7), b = sg / 65, s = sg - 65 * b;
            __builtin_amdgcn_global_load_lds((const unsigned*)(rstd + (size_t)(b * SEQ + 126 * s + (t_ & 127)) * 4), (LAS unsigned*)(prm + wid * 1024), 16, 0, 0); }
#pragma unroll
        for (int h = 0; h < 2; ++h) {
            const int idx = t_ + 512 * h, a = idx >> 7, c = idx & 127, k = a & 3, col = (a >> 2) * 3072 + 128 * u.pn + c;
            const float* src = (k < 3) ? (cw + k * 6144 + col) : (cb + col);
            __builtin_amdgcn_global_load_lds((const unsigned*)src, (LAS unsigned*)(prm + 4096 + (wid + 8 * h) * 256), 4, 0, 0);
        }
    }
    __device__ __forceinline__ void operator()(Acc& acc, const Unit& u, int wr, int wc, int fr, int fq, LAS unsigned char* prm) const {
        { int t_ = threadIdx.x; asm volatile("" : "+v"(t_)); fr = t_ & 15; fq = (t_ >> 4) & 3; }
        rstd_to_lds(prm);
        const int sg = 2 * u.pm + wr, b = sg / 65, s = sg - 65 * b;
        const int rowbase = b * SEQ + 126 * s + fr * 8;
#pragma unroll
        for (int ai = 0; ai < 2; ++ai)
#pragma unroll
            for (int m = 0; m < 4; ++m) {
                const float rs = ((const LAS float*)prm)[2304 + wr * 128 + fr * 8 + ai * 4 + m];
#pragma unroll
                for (int bj = 0; bj < 2; ++bj)
#pragma unroll
                    for (int n = 0; n < 2; ++n) acc[ai][bj][m][n] *= rs;
            }
        __builtin_amdgcn_sched_barrier(0);
        const int ch0 = 128 * u.pn + 32 * wc + 8 * fq;
#pragma unroll
        for (int n = 0; n < 2; ++n) {
            const int ch = ch0 + 4 * n;
            const LAS float* pw = (const LAS float*)prm + 1024 + 32 * wc + 8 * fq + 4 * n;
            const f32x4 g0 = *(const LAS f32x4*)(pw), g1 = *(const LAS f32x4*)(pw + 128), g2 = *(const LAS f32x4*)(pw + 256), gb = *(const LAS f32x4*)(pw + 384);
            const f32x4 v0 = *(const LAS f32x4*)(pw + 512), v1 = *(const LAS f32x4*)(pw + 640), v2 = *(const LAS f32x4*)(pw + 768), vb = *(const LAS f32x4*)(pw + 896);
            f32x4 pg1 = shfl_up4(acc[1][0][3][n], 1), pg2 = shfl_up4(acc[1][0][2][n], 1);
            f32x4 pv1 = shfl_up4(acc[1][1][3][n], 1), pv2 = shfl_up4(acc[1][1][2][n], 1);
            if (fr == 0) { pg1 = (f32x4){0.f, 0.f, 0.f, 0.f}; pg2 = pg1; pv1 = pg1; pv2 = pg1; }
#pragma unroll
            for (int ai = 0; ai < 2; ++ai)
#pragma unroll
                for (int m = 0; m < 4; ++m) {
                    const f32x4 yg = acc[ai][0][m][n], yv = acc[ai][1][m][n];
                    const f32x4 ug = gb + g0 * pg2 + g1 * pg1 + g2 * yg;
                    const f32x4 uv = vb + v0 * pv2 + v1 * pv1 + v2 * yv;
                    pg2 = pg1; pg1 = yg; pv2 = pv1; pv1 = yv;
                    acc[ai][0][m][n] = gelu_mul4(ug, uv);
                }
            __builtin_amdgcn_sched_barrier(0);
        }
        __builtin_amdgcn_sched_barrier(0);
        bf16_t* const obase = O + (size_t)(ch0 >> 6) * ((size_t)M_TOK * 64) + (size_t)rowbase * 64 + (ch0 & 63);
#pragma unroll
        for (int ai = 0; ai < 2; ++ai)
#pragma unroll
            for (int m = 0; m < 4; ++m) {
                const int jj = ai * 4 + m;
                if (s == 0 || fr * 8 + jj >= 2) {
                    const f32x4 a0 = acc[ai][0][m][0], a1 = acc[ai][0][m][1];
                    u32x4 w; w.x = pk2(a0[0], a0[1]); w.y = pk2(a0[2], a0[3]); w.z = pk2(a1[0], a1[1]); w.w = pk2(a1[2], a1[3]);
                    *(u32x4*)(obase + jj * 64) = w;
                }
            }
    }
};

struct EpiIn {
    static constexpr bool PEEL = false;
    static constexpr bool RT_KSTEP = false;
    __device__ __forceinline__ void prefetch(LAS unsigned char* prm, const Unit& u, int wid) const {
        int t_ = threadIdx.x; asm volatile("" : "+v"(t_));
        if (wid < 4) { const int sg = 2 * u.pm + (t_ >> 7), b = sg / 66, s = sg - 66 * b; int rr = b * SEQ + 125 * s + (t_ & 127); rr = rr < M_TOK ? rr : M_TOK - 1;
            __builtin_amdgcn_global_load_lds((const unsigned*)(rstd + (size_t)rr * 4), (LAS unsigned*)(prm + wid * 1024), 16, 0, 0); }
        if (u.pn < 4) {
#pragma unroll
            for (int h = 0; h < 2; ++h) {
                const int idx = t_ + 512 * h, k = idx >> 8, c = idx & 255;
                __builtin_amdgcn_global_load_lds((const unsigned*)(cw + k * 1024 + 256 * u.pn + c), (LAS unsigned*)(prm + 4096 + (wid + 8 * h) * 256), 4, 0, 0);
            }
            if (wid < 4) __builtin_amdgcn_global_load_lds((const unsigned*)(cb + 256 * u.pn + t_), (LAS unsigned*)(prm + 4096 + (wid + 16) * 256), 4, 0, 0);
        }
    }
    bf16_t* XC; bf16_t* GATE; const float* rstd; const float* cw; const float* cb;
    __device__ __forceinline__ void operator()(Acc& acc, const Unit& u, int wr, int wc, int fr, int fq, LAS unsigned char* prm) const {
        { int t_ = threadIdx.x; asm volatile("" : "+v"(t_)); fr = t_ & 15; fq = (t_ >> 4) & 3; }
        rstd_to_lds(prm);
        const int sg = 2 * u.pm + wr, b = sg / 66, s = sg - 66 * b;
        const int tl0 = 125 * s + fr * 8, rowbase = b * SEQ + tl0;
#pragma unroll
        for (int ai = 0; ai < 2; ++ai)
#pragma unroll
            for (int m = 0; m < 4; ++m) {
                int rr = rowbase + ai * 4 + m; rr = rr < M_TOK ? rr : M_TOK - 1;
                const float rs = ((const LAS float*)prm)[2304 + wr * 128 + fr * 8 + ai * 4 + m];
#pragma unroll
                for (int bj = 0; bj < 2; ++bj)
#pragma unroll
                    for (int n = 0; n < 2; ++n) acc[ai][bj][m][n] *= rs;
            }
        bf16_t* OUT; int colbase;
        if (u.pn < 4) {
            OUT = XC; colbase = 256 * u.pn + 32 * wc + 8 * fq;
#pragma unroll
            for (int bj = 0; bj < 2; ++bj)
#pragma unroll
                for (int n = 0; n < 2; ++n) {
                    const int ch = colbase + 128 * bj + 4 * n;
                    const LAS float* pw = (const LAS float*)prm + 1024 + 128 * bj + 32 * wc + 8 * fq + 4 * n;
                    const f32x4 w0 = *(const LAS f32x4*)(pw), w1 = *(const LAS f32x4*)(pw + 256), w2 = *(const LAS f32x4*)(pw + 512), w3 = *(const LAS f32x4*)(pw + 768), bb = *(const LAS f32x4*)(pw + 1024);
                    f32x4 p1 = shfl_up4(acc[1][bj][3][n], 1), p2 = shfl_up4(acc[1][bj][2][n], 1), p3 = shfl_up4(acc[1][bj][1][n], 1);
                    if (fr == 0) { p1 = (f32x4){0.f, 0.f, 0.f, 0.f}; p2 = p1; p3 = p1; }
#pragma unroll
                    for (int ai = 0; ai < 2; ++ai)
#pragma unroll
                        for (int m = 0; m < 4; ++m) {
                            const f32x4 y = acc[ai][bj][m][n];
                            acc[ai][bj][m][n] = bb + w0 * p3 + w1 * p2 + w2 * p1 + w3 * y;
                            p3 = p2; p2 = p1; p1 = y;
                        }
                    __builtin_amdgcn_sched_barrier(0);
                }
        } else {
            OUT = GATE; colbase = 256 * (u.pn - 4) + 32 * wc + 8 * fq;
        }
#pragma unroll
        for (int ai = 0; ai < 2; ++ai)
#pragma unroll
            for (int m = 0; m < 4; ++m) {
                const int jj = ai * 4 + m;
                if ((s == 0 || fr * 8 + jj >= 3) && (tl0 + jj < SEQ)) {
#pragma unroll
                    for (int bj = 0; bj < 2; ++bj) {
                        f32x4 a0 = acc[ai][bj][m][0], a1 = acc[ai][bj][m][1];
                        if (u.pn >= 4) {
                            a0 = gelu_mul4(a0, (f32x4){1.f, 1.f, 1.f, 1.f}); a1 = gelu_mul4(a1, (f32x4){1.f, 1.f, 1.f, 1.f});
                        }
                        u32x4 w; w.x = pk2(a0[0], a0[1]); w.y = pk2(a0[2], a0[3]); w.z = pk2(a1[0], a1[1]); w.w = pk2(a1[2], a1[3]);
                        *(u32x4*)(OUT + (size_t)(rowbase + jj) * 1024 + colbase + 128 * bj) = w;
                    }
                }
            }
    }
};

struct EpiGate {
    static constexpr bool PEEL = false;
    static constexpr bool RT_KSTEP = false;
    const bf16_t* XC; bf16_t* HLOC; bf16_t* PCUM; float* CEP; float* CEH; const float* gab; const float* gxb; const float* lam;
    __device__ __forceinline__ void prefetch(LAS unsigned char* prm, const Unit& u, int wid) const {
        if (wid < 6) { int t_ = threadIdx.x; asm volatile("" : "+v"(t_));
            const int c = t_ & 127, chb = 256 * (u.pn >> 1) + 128 * (u.pn & 1);
            if (wid < 2)      __builtin_amdgcn_global_load_lds((const unsigned*)(gab + chb + c), (LAS unsigned*)(prm + wid * 256), 4, 0, 0);
            else if (wid < 4) __builtin_amdgcn_global_load_lds((const unsigned*)(gxb + chb + c), (LAS unsigned*)(prm + wid * 256), 4, 0, 0);
            else              __builtin_amdgcn_global_load_lds((const unsigned*)(lam + chb + c), (LAS unsigned*)(prm + wid * 256), 4, 0, 0); }
    }
    __device__ __forceinline__ void operator()(Acc& acc, const Unit& u, int wr, int wc, int fr, int fq, LAS unsigned char* prm) const {
        { int t_ = threadIdx.x; asm volatile("" : "+v"(t_)); fr = t_ & 15; fq = (t_ >> 4) & 3; }
        const int sg = 2 * u.pm + wr;
        const int rowbase = sg * 128 + fr * 8;
        const int ch0 = 256 * (u.pn >> 1) + 128 * (u.pn & 1) + 32 * wc + 8 * fq;
        u32x2 xwv[2][8];
#pragma unroll
        for (int n = 0; n < 2; ++n)
#pragma unroll
            for (int jj = 0; jj < 8; ++jj) xwv[n][jj] = *(const u32x2*)(XC + (size_t)(rowbase + jj) * 1024 + ch0 + 4 * n);
#pragma unroll
        for (int n = 0; n < 2; ++n) {
            const int ch = ch0 + 4 * n;
            const LAS float* pp = (const LAS float*)prm + 32 * wc + 8 * fq + 4 * n;
            const f32x4 ba = *(const LAS f32x4*)(pp) * (-LOG2E), bx = *(const LAS f32x4*)(pp + 128) * (-LOG2E), lm = *(const LAS f32x4*)(pp + 256);
            f32x4 L2;
#pragma unroll
            for (int e = 0; e < 4; ++e) { const float x = lm[e]; L2[e] = (8.0f * LOG2E) * (fminf(x, 0.f) - __logf(1.0f + __expf(-fabsf(x)))); }
            f32x4 P = (f32x4){1.f, 1.f, 1.f, 1.f}, H = (f32x4){0.f, 0.f, 0.f, 0.f};
#pragma unroll
            for (int ai = 0; ai < 2; ++ai)
#pragma unroll
                for (int m = 0; m < 4; ++m) {
                    const int jj = ai * 4 + m;
                    const u32x2 xw = xwv[n][jj];
                    const f32x4 xc = (f32x4){bflo(xw.x), bfhi(xw.x), bflo(xw.y), bfhi(xw.y)};
                    const f32x4 tr = acc[ai][0][m][n] * (-LOG2E) + ba, tx = acc[ai][1][m][n] * (-LOG2E) + bx;
                    f32x4 er, ex;
#pragma unroll
                    for (int e = 0; e < 4; ++e) { er[e] = __builtin_amdgcn_exp2f(fminf(tr[e], 60.f)); ex[e] = __builtin_amdgcn_exp2f(fminf(tx[e], 60.f)); }
                    const f32x4 dr = er + 1.0f, dx = ex + 1.0f, dd = dr * dx;
                    f32x4 q;
#pragma unroll
                    for (int e = 0; e < 4; ++e) q[e] = __builtin_amdgcn_rcpf(dd[e]);
                    const f32x4 r = q * dx, ig = q * dr, la2 = L2 * r;
                    f32x4 av, mu;
#pragma unroll
                    for (int e = 0; e < 4; ++e) av[e] = __builtin_amdgcn_exp2f(la2[e]);
                    const f32x4 om = av * av * (-1.0f) + 1.0f;
#pragma unroll
                    for (int e = 0; e < 4; ++e) mu[e] = __builtin_amdgcn_sqrtf(fmaxf(om[e], 0.f));
                    H = av * H + mu * ig * xc; P = P * av;
                    acc[ai][0][m][n] = P; acc[ai][1][m][n] = H;
                    if (m == 3) __builtin_amdgcn_sched_barrier(0);
                }
            f32x4 Pi = P, Hi = H;
#pragma unroll
            for (int d = 1; d < 16; d <<= 1) {
                const f32x4 Pp = shfl_up4(Pi, d), Hp = shfl_up4(Hi, d);
                if (fr >= d) { Hi = Pi * Hp + Hi; Pi = Pi * Pp; }
            }
            f32x4 Pe = shfl_up4(Pi, 1), He = shfl_up4(Hi, 1);
            if (fr == 0) { Pe = (f32x4){1.f, 1.f, 1.f, 1.f}; He = (f32x4){0.f, 0.f, 0.f, 0.f}; }
            if (fr == 15) { *(f32x4*)(CEP + (size_t)sg * 1024 + ch) = Pi; *(f32x4*)(CEH + (size_t)sg * 1024 + ch) = Hi; }
#pragma unroll
            for (int ai = 0; ai < 2; ++ai)
#pragma unroll
                for (int m = 0; m < 4; ++m) {
                    const f32x4 p = acc[ai][0][m][n], h = acc[ai][1][m][n];
                    acc[ai][1][m][n] = h + p * He; acc[ai][0][m][n] = p * Pe;
                }
            __builtin_amdgcn_sched_barrier(0);
        }
#pragma unroll
        for (int ai = 0; ai < 2; ++ai)
#pragma unroll
            for (int m = 0; m < 4; ++m) {
                const int jj = ai * 4 + m;
                const size_t o = (size_t)(rowbase + jj) * 1024 + ch0;
                { const f32x4 a0 = acc[ai][0][m][0], a1 = acc[ai][0][m][1]; u32x4 w; w.x = pk2(a0[0], a0[1]); w.y = pk2(a0[2], a0[3]); w.z = pk2(a1[0], a1[1]); w.w = pk2(a1[2], a1[3]); *(u32x4*)(PCUM + o) = w; }
                { const f32x4 a0 = acc[ai][1][m][0], a1 = acc[ai][1][m][1]; u32x4 w; w.x = pk2(a0[0], a0[1]); w.y = pk2(a0[2], a0[3]); w.z = pk2(a1[0], a1[1]); w.w = pk2(a1[2], a1[3]); *(u32x4*)(HLOC + o) = w; }
            }
    }
};

struct EpiRes {
    static constexpr bool PEEL = false;
    static constexpr bool RT_KSTEP = true;
    __device__ __forceinline__ void prefetch(LAS unsigned char*, const Unit&, int) const {}
    bf16_t* XB; float* P2; unsigned long long* GRAN; const float* gpost; float* out; unsigned epoch; LAS float* sm; LAS float* rs1;
    __device__ __forceinline__ void operator()(Acc& acc, const Unit& u, int wr, int wc, int fr, int fq, LAS unsigned char* prm) const {
        int tid; { int t_ = threadIdx.x; asm volatile("" : "+v"(t_)); tid = t_; fr = t_ & 15; fq = (t_ >> 4) & 3; }
        const int col0 = u.pn * 256 + wc * 32 + 8 * fq;
        u32x4 xwv[2][4][2];
#pragma unroll
        for (int ai = 0; ai < 2; ++ai)
#pragma unroll
            for (int m = 0; m < 4; ++m)
#pragma unroll
                for (int bj = 0; bj < 2; ++bj)
                    xwv[ai][m][bj] = *(const u32x4*)(XB + (size_t)(u.pm * 256 + ai * 128 + wr * 64 + m * 16 + fr) * DM + col0 + bj * 128);
        f32x4 gp[2][2];
#pragma unroll
        for (int bj = 0; bj < 2; ++bj)
#pragma unroll
            for (int n = 0; n < 2; ++n) gp[bj][n] = *(const f32x4*)(gpost + col0 + bj * 128 + 4 * n);
#pragma unroll
        for (int ai = 0; ai < 2; ++ai)
#pragma unroll
            for (int m = 0; m < 4; ++m) {
                float s = 0.f;
#pragma unroll
                for (int bj = 0; bj < 2; ++bj)
#pragma unroll
                    for (int n = 0; n < 2; ++n) { const f32x4 v = acc[ai][bj][m][n]; s += (v[0] * v[0] + v[1] * v[1]) + (v[2] * v[2] + v[3] * v[3]); }
                s += __shfl_xor(s, 16); s += __shfl_xor(s, 32);
                if (fq == 0) sm[wc * 256 + ai * 128 + wr * 64 + m * 16 + fr] = s;
            }
        asm volatile("s_waitcnt lgkmcnt(0)" ::: "memory"); __builtin_amdgcn_s_barrier(); asm volatile("" ::: "memory");
        if (tid < 256) {
            const float mine = (sm[tid] + sm[256 + tid]) + (sm[512 + tid] + sm[768 + tid]);
            unsigned long long* gbase = GRAN + (size_t)u.pm * 1024 + tid;
            __hip_atomic_store(gbase + u.pn * 256, ((unsigned long long)epoch << 32) | (unsigned long long)__float_as_uint(mine), __ATOMIC_RELAXED, __HIP_MEMORY_SCOPE_AGENT);
            float part[4];
            unsigned spins = 0;
            for (;;) {
                bool ok = true;
#pragma unroll
                for (int k = 0; k < 4; ++k) {
                    const unsigned long long x = __hip_atomic_load(gbase + k * 256, __ATOMIC_RELAXED, __HIP_MEMORY_SCOPE_AGENT);
                    part[k] = __uint_as_float((unsigned)x); ok &= ((unsigned)(x >> 32) == epoch);
                }
                if (__all(ok)) break;
                __builtin_amdgcn_s_sleep(1);
                if (++spins > (1u << 22)) break;
            }
            const float tot = (part[0] + part[1]) + (part[2] + part[3]);
            rs1[tid] = 1.0f / sqrtf(tot * (1.0f / DM) + RMS_EPS);
        }
        asm volatile("s_waitcnt lgkmcnt(0)" ::: "memory"); __builtin_amdgcn_s_barrier(); asm volatile("" ::: "memory");
#pragma unroll
        for (int ai = 0; ai < 2; ++ai)
#pragma unroll
            for (int m = 0; m < 4; ++m) {
                const int rl = ai * 128 + wr * 64 + m * 16 + fr;
                const float rs = rs1[rl];
                const size_t ro = (size_t)(u.pm * 256 + rl) * DM + col0;
                float s2 = 0.f;
#pragma unroll
                for (int bj = 0; bj < 2; ++bj) {
                    const u32x4 xw = xwv[ai][m][bj];
                    f32x4 x0, x1;
                    x0[0] = bflo(xw.x); x0[1] = bfhi(xw.x); x0[2] = bflo(xw.y); x0[3] = bfhi(xw.y);
                    x1[0] = bflo(xw.z); x1[1] = bfhi(xw.z); x1[2] = bflo(xw.w); x1[3] = bfhi(xw.w);
                    x0 += acc[ai][bj][m][0] * rs * gp[bj][0]; x1 += acc[ai][bj][m][1] * rs * gp[bj][1];
                    s2 += (x0[0] * x0[0] + x0[1] * x0[1]) + (x0[2] * x0[2] + x0[3] * x0[3]) + (x1[0] * x1[0] + x1[1] * x1[1]) + (x1[2] * x1[2] + x1[3] * x1[3]);
                    u32x4 w; w.x = pk2(x0[0], x0[1]); w.y = pk2(x0[2], x0[3]); w.z = pk2(x1[0], x1[1]); w.w = pk2(x1[2], x1[3]);
                    *(u32x4*)(XB + ro + bj * 128) = w;
                    if (out) { *(f32x4*)(out + ro + bj * 128) = x0; *(f32x4*)(out + ro + bj * 128 + 4) = x1; }
                }
                s2 += __shfl_xor(s2, 16); s2 += __shfl_xor(s2, 32);
                if (fq == 0) sm[wc * 256 + rl] = s2;
            }
        asm volatile("s_waitcnt lgkmcnt(0)" ::: "memory"); __builtin_amdgcn_s_barrier(); asm volatile("" ::: "memory");
        if (tid < 256) P2[(size_t)(u.pm * 256 + tid) * 4 + u.pn] = (sm[tid] + sm[256 + tid]) + (sm[512 + tid] + sm[768 + tid]);
    }
};

struct Params {
    const float* in[21];
    float* out;
    unsigned char* ws;
    unsigned char bucket[3 * 136];
};
constexpr size_t MiB = 1024 * 1024;
constexpr size_t WS_WQKV = 0;
constexpr size_t WS_WO   = WS_WQKV + (size_t)2 * 9216 * 1024 * 2;
constexpr size_t WS_WIN  = WS_WO + (size_t)2 * 1024 * 1024 * 2;
constexpr size_t WS_WG   = WS_WIN + (size_t)2 * 2048 * 1024 * 2;
constexpr size_t WS_WOUT = WS_WG + (size_t)2 * 4 * 512 * 256 * 2;
constexpr size_t WS_WUP  = WS_WOUT + (size_t)2 * 1024 * 1024 * 2;
constexpr size_t WS_WDN  = WS_WUP + (size_t)4 * 6144 * 1024 * 2;
constexpr size_t WS_XB   = WS_WDN + (size_t)4 * 1024 * 3072 * 2;
constexpr size_t WS_ACT  = WS_XB + 64 * MiB;
constexpr size_t WS_RSTD = WS_ACT + 256 * MiB;
constexpr size_t WS_LSE  = WS_RSTD + 128 * 1024;
constexpr size_t WS_CEP  = WS_LSE + 1 * MiB;
constexpr size_t WS_CEH  = WS_CEP + 1 * MiB;
constexpr size_t WS_BAR  = WS_CEH + 1 * MiB;
constexpr size_t WS_GRAN = WS_BAR + 16384;
constexpr size_t WS_P2   = WS_GRAN + 2 * MiB;
constexpr size_t WS_END  = WS_P2 + 512 * 1024;

constexpr int LDS_BYTES = 160 * 1024;
constexpr int MISC_OFF = STAGE_BYTES;

struct TDesc { const float* W; const float* gain; bf16_t* WT; int K, N, ldw, map, blocked; };
__device__ __forceinline__ int map_row(int map, int n) {
    if (map == 0) return n;
    if (map == 1) return 256 * (n >> 7) + (n & 127);
    if (map == 2) return 256 * (n >> 7) + 128 + (n & 127);
    const int bj = n >= 3072 ? 1 : 0, jn = n - 3072 * bj; return 256 * (jn >> 7) + 128 * bj + (jn & 127);
}
__device__ __forceinline__ void tr_load(const TDesc& d, int item, int lane, float (&v)[32]) {
    const int nblk = d.N / 32, kb = item / nblk, nb = item % nblk, k0 = 64 * kb, n0 = 32 * nb;
    const float* src = d.W + (size_t)(k0 + (lane >> 5)) * d.ldw + n0 + (lane & 31);
#pragma unroll
    for (int i = 0; i < 32; ++i) v[i] = src[(size_t)(2 * i) * d.ldw];
}
__device__ __forceinline__ void tr_store(const TDesc& d, LAS float* scr, int item, int lane, const float (&v)[32]) {
    const int nblk = d.N / 32, kb = item / nblk, nb = item % nblk, k0 = 64 * kb, n0 = 32 * nb;
    const int c = lane & 7;
    f32x4 g0 = (f32x4){1.f, 1.f, 1.f, 1.f}, g1 = g0;
    if (d.gain) { g0 = *(const f32x4*)(d.gain + k0 + 8 * c); g1 = *(const f32x4*)(d.gain + k0 + 8 * c + 4); }
#pragma unroll
    for (int i = 0; i < 32; ++i) scr[(2 * i + (lane >> 5)) * 33 + (lane & 31)] = v[i];
    asm volatile("s_waitcnt lgkmcnt(0)" ::: "memory");
#pragma unroll
    for (int j = 0; j < 4; ++j) { const int n = (lane >> 3) + 8 * j; const LAS float* s = scr + (8 * c) * 33 + n;
        u32x4 o; o.x = pk2(s[0 * 33] * g0[0], s[1 * 33] * g0[1]); o.y = pk2(s[2 * 33] * g0[2], s[3 * 33] * g0[3]); o.z = pk2(s[4 * 33] * g1[0], s[5 * 33] * g1[1]); o.w = pk2(s[6 * 33] * g1[2], s[7 * 33] * g1[3]);
        bf16_t* dst = d.blocked ? d.WT + (size_t)kb * ((size_t)d.N * 64) + (size_t)map_row(d.map, n0 + n) * 64 + 8 * c : d.WT + (size_t)map_row(d.map, n0 + n) * d.K + k0 + 8 * c;
        *(u32x4*)dst = o; }
    asm volatile("s_waitcnt lgkmcnt(0)" ::: "memory");
}
__device__ __forceinline__ int tr_desc(const Params& p, int it, TDesc& d) {
    unsigned char* ws = p.ws; int r;
    constexpr int IT_QKV = 16 * 288, IT_SQ = 16 * 32, IT_IN = 16 * 64, IT_G = 4 * 8, IT_UP = 16 * 192, IT_DN = 48 * 32;
    constexpr int C0 = 2 * IT_QKV, C1 = C0 + 2 * IT_SQ, C2 = C1 + 2 * IT_IN, C3 = C2 + 16 * IT_G, C4 = C3 + 2 * IT_SQ, C5 = C4 + 4 * IT_UP;
    if (it < C0) { const int j = it / IT_QKV; r = it - j * IT_QKV; d.W = p.in[6] + (size_t)j * 1024 * 9216; d.gain = p.in[1] + (2 * j) * 1024; d.WT = (bf16_t*)(ws + WS_WQKV) + (size_t)j * 9216 * 1024; d.K = 1024; d.N = 9216; d.ldw = 9216; d.map = 0; d.blocked = 0; }
    else if (it < C1) { const int q = it - C0, j = q / IT_SQ; r = q - j * IT_SQ; d.W = p.in[7] + (size_t)j * 1024 * 1024; d.gain = nullptr; d.WT = (bf16_t*)(ws + WS_WO) + (size_t)j * 1024 * 1024; d.K = 1024; d.N = 1024; d.ldw = 1024; d.map = 0; d.blocked = 0; }
    else if (it < C2) { const int q = it - C1, j = q / IT_IN; r = q - j * IT_IN; d.W = p.in[8] + (size_t)j * 1024 * 2048; d.gain = p.in[1] + (2 * j + 1) * 1024; d.WT = (bf16_t*)(ws + WS_WIN) + (size_t)j * 2048 * 1024; d.K = 1024; d.N = 2048; d.ldw = 2048; d.map = 0; d.blocked = 0; }
    else if (it < C3) { const int q = it - C2, mi = q / IT_G; r = q - mi * IT_G; const int which = mi >> 3, jn = mi & 7;
        d.W = (which ? p.in[13] : p.in[11]) + (size_t)jn * 65536; d.gain = nullptr; d.WT = (bf16_t*)(ws + WS_WG) + (size_t)jn * 512 * 256; d.K = 256; d.N = 256; d.ldw = 256; d.map = 1 + which; d.blocked = 0; }
    else if (it < C4) { const int q = it - C3, j = q / IT_SQ; r = q - j * IT_SQ; d.W = p.in[16] + (size_t)j * 1024 * 1024; d.gain = nullptr; d.WT = (bf16_t*)(ws + WS_WOUT) + (size_t)j * 1024 * 1024; d.K = 1024; d.N = 1024; d.ldw = 1024; d.map = 0; d.blocked = 0; }
    else if (it < C5) { const int q = it - C4, l = q / IT_UP; r = q - l * IT_UP; d.W = p.in[17] + (size_t)l * 1024 * 6144; d.gain = p.in[3] + l * 1024; d.WT = (bf16_t*)(ws + WS_WUP) + (size_t)l * 6144 * 1024; d.K = 1024; d.N = 6144; d.ldw = 6144; d.map = 3; d.blocked = 0; }
    else { const int q = it - C5, l = q / IT_DN; r = q - l * IT_DN; d.W = p.in[20] + (size_t)l * 3072 * 1024; d.gain = nullptr; d.WT = (bf16_t*)(ws + WS_WDN) + (size_t)l * 1024 * 3072; d.K = 3072; d.N = 1024; d.ldw = 1024; d.map = 0; d.blocked = 1; }
    return r;
}
__device__ __forceinline__ void prologue(const Params& p, LAS unsigned char* lds, int gw, int NGW, int wave) {
    int lane; { int t_ = threadIdx.x; asm volatile("" : "+v"(t_)); lane = t_ & 63; }
    LAS float* scr = (LAS float*)(lds + wave * 8448);
    unsigned char* ws = p.ws;
    constexpr int NITEMS = 2 * 16 * 288 + 2 * 16 * 32 + 2 * 16 * 64 + 16 * 32 + 2 * 16 * 32 + 4 * 16 * 192 + 4 * 48 * 32;
    {
        int it = gw;
        TDesc d; int r = 0; float a[32];
        if (it < NITEMS) { r = tr_desc(p, it, d); tr_load(d, r, lane, a); }
        while (it < NITEMS) {
            const int nit = it + NGW;
            TDesc dn; int rn = 0; float b[32];
            if (nit < NITEMS) { rn = tr_desc(p, nit, dn); tr_load(dn, rn, lane, b); }
            __builtin_amdgcn_sched_barrier(0);
            tr_store(d, scr, r, lane, a);
            __builtin_amdgcn_sched_barrier(0);
            if (nit < NITEMS) {
                d = dn; r = rn;
#pragma unroll
                for (int i = 0; i < 32; ++i) a[i] = b[i];
            }
            it = nit;
        }
    }
    const float* x = p.in[0]; bf16_t* XB = (bf16_t*)(ws + WS_XB); float* P2 = (float*)(ws + WS_P2);
    for (int m0 = gw * 4; m0 < M_TOK; m0 += NGW * 4) {
        f32x4 v[4][4]; float ss[4];
#pragma unroll
        for (int r = 0; r < 4; ++r) { const f32x4* xr = (const f32x4*)(x + (size_t)(m0 + r) * DM) + lane;
#pragma unroll
            for (int j = 0; j < 4; ++j) v[r][j] = xr[64 * j]; }
#pragma unroll
        for (int r = 0; r < 4; ++r) { float s = 0.f;
#pragma unroll
            for (int j = 0; j < 4; ++j) s += (v[r][j][0] * v[r][j][0] + v[r][j][1] * v[r][j][1]) + (v[r][j][2] * v[r][j][2] + v[r][j][3] * v[r][j][3]);
            ss[r] = s; }
#pragma unroll
        for (int o = 1; o < 64; o <<= 1) {
#pragma unroll
            for (int r = 0; r < 4; ++r) ss[r] += __shfl_xor(ss[r], o);
        }
#pragma unroll
        for (int r = 0; r < 4; ++r) {
            u32x2* o8 = (u32x2*)(XB + (size_t)(m0 + r) * DM) + lane;
#pragma unroll
            for (int j = 0; j < 4; ++j) { u32x2 w; w.x = pk2(v[r][j][0], v[r][j][1]); w.y = pk2(v[r][j][2], v[r][j][3]); o8[64 * j] = w; }
            if (lane == 0) *(f32x4*)(P2 + (size_t)(m0 + r) * 4) = (f32x4){ss[r], 0.f, 0.f, 0.f};
        }
    }
    { unsigned long long* G8 = (unsigned long long*)(ws + WS_GRAN); for (int i = gw * 64 + lane; i < 262144; i += NGW * 64) G8[i] = 0ull; }
}

__device__ __forceinline__ void lru_apply(const bf16_t* HLOC, const bf16_t* PCUM, const bf16_t* GATE, bf16_t* HA, const float* CEP, const float* CEH) {
    int tid_ = threadIdx.x; asm volatile("" : "+v"(tid_));
    const int tid = tid_, cgp = tid & 127, rsl = tid >> 7, ch = 8 * cgp;
    for (int sg = blockIdx.x; sg < 256; sg += gridDim.x) {
        const int b = sg >> 6, c = sg & 63;
        float carry[8];
#pragma unroll
        for (int e = 0; e < 8; ++e) carry[e] = 0.f;
        for (int k0 = 0; k0 < c; k0 += 4) {
            f32x4 pq[4][2], hq[4][2];
#pragma unroll
            for (int i = 0; i < 4; ++i) {
                const int k = (k0 + i < c) ? (k0 + i) : (c - 1);
                const size_t o = (size_t)(b * 64 + k) * 1024 + ch;
                pq[i][0] = *(const f32x4*)(CEP + o); pq[i][1] = *(const f32x4*)(CEP + o + 4); hq[i][0] = *(const f32x4*)(CEH + o); hq[i][1] = *(const f32x4*)(CEH + o + 4);
            }
            __builtin_amdgcn_sched_barrier(0);
#pragma unroll
            for (int i = 0; i < 4; ++i) {
                if (k0 + i < c) {
#pragma unroll
                    for (int e = 0; e < 4; ++e) { carry[e] = pq[i][0][e] * carry[e] + hq[i][0][e]; carry[4 + e] = pq[i][1][e] * carry[4 + e] + hq[i][1][e]; }
                }
            }
        }
        for (int r0 = 0; r0 < 32; r0 += 4) {
            u32x4 hl[4], pc[4], gt[4];
#pragma unroll
            for (int i = 0; i < 4; ++i) {
                const size_t o = (size_t)(sg * 128 + rsl * 32 + r0 + i) * 1024 + ch;
                hl[i] = *(const u32x4*)(HLOC + o); pc[i] = *(const u32x4*)(PCUM + o); gt[i] = *(const u32x4*)(GATE + o);
            }
            __builtin_amdgcn_sched_barrier(0);
#pragma unroll
            for (int i = 0; i < 4; ++i) {
                const size_t o = (size_t)(sg * 128 + rsl * 32 + r0 + i) * 1024 + ch;
                u32x4 w;
#pragma unroll
                for (int q = 0; q < 4; ++q) {
                    const float v0 = (bflo(hl[i][q]) + bflo(pc[i][q]) * carry[2 * q]) * bflo(gt[i][q]);
                    const float v1 = (bfhi(hl[i][q]) + bfhi(pc[i][q]) * carry[2 * q + 1]) * bfhi(gt[i][q]);
                    w[q] = pk2(v0, v1);
                }
                *(u32x4*)(HA + o) = w;
            }
        }
    }
}

__device__ __forceinline__ unsigned off_b(unsigned row, unsigned ch) { return 256u * row + 16u * (ch ^ (((row & 3) << 2) | ((row >> 2) & 3))); }
__device__ __forceinline__ unsigned tr_addr16(unsigned lane, unsigned c, unsigned ks, unsigned t) {
    const unsigned g = lane >> 4, q = (lane & 15) >> 2, pp = lane & 3;
    return off_b(32 * ks + 8 * g + 4 * t + q, 2 * c + (pp >> 1)) + 8 * (pp & 1);
}
__device__ __forceinline__ void attn_phase(const Params& p, LAS unsigned char* lds, const bf16_t* QKV, bf16_t* OB, float* LSE, int g) {
    int tid_ = threadIdx.x; asm volatile("" : "+v"(tid_));
    const int tid = tid_, lane = tid & 63, w = __builtin_amdgcn_readfirstlane(tid >> 6), fr = lane & 15, fq = lane >> 4;
    const int dshift = 2 * g, csb = 4 - 2 * g;
    LAS float* bt = (LAS float*)(lds + MISC_OFF + 26624);
    const float* rel_bias = p.in[5];
    const float sc2 = 0.08838834764831845f * LOG2E;
    for (int ck = blockIdx.x; ck < 512; ck += gridDim.x) {
        const int idx16 = ck & 15, bh = ck >> 4, b = bh >> 3, h = bh & 7;
        const int x = idx16 >> csb, cseq = idx16 & ((1 << csb) - 1), n_start = 4 * cseq;
        const size_t tokbase = (size_t)b * SEQ + x;
        for (int e = tid; e < 1024; e += 512) {
            const int r = e >> 8, idx = e & 255, m = 160 + r - idx;
            const int mc = m < 0 ? 0 : (m > 128 ? 128 : m);
            const float bv = rel_bias[(int)p.bucket[g * 136 + mc] * 24 + g * 8 + h] * LOG2E;
            bt[e] = (m >= 0 && m <= 128) ? bv : -1e30f;
        }
        u32x4 pre[8];
#pragma unroll
        for (int i = 0; i < 4; ++i) {
            const int c = tid + 512 * i, row = c >> 4, chn = c & 15;
            if (n_start > 0) {
                const size_t tk = tokbase + ((size_t)((n_start - 1) * 128 + row) << dshift);
                const bf16_t* src = QKV + ((size_t)(8 + h) * M_TOK + tk) * 128 + chn * 8;
                pre[i] = *(const u32x4*)src; pre[4 + i] = *(const u32x4*)(src + (size_t)8 * M_TOK * 128);
            } else { pre[i] = (u32x4){0u, 0u, 0u, 0u}; pre[4 + i] = pre[i]; }
        }
#pragma unroll
        for (int i = 0; i < 4; ++i) { const int c = tid + 512 * i, row = c >> 4, chn = c & 15; const unsigned o = off_b(row, chn);
            *(LAS u32x4*)(lds + 65536 + o) = pre[i]; *(LAS u32x4*)(lds + 65536 + 32768 + o) = pre[4 + i]; }
#pragma unroll
        for (int i = 0; i < 4; ++i) {
            const int c = tid + 512 * i, row = c >> 4, chn = c & 15;
            const size_t tk = tokbase + ((size_t)(n_start * 128 + row) << dshift);
            const bf16_t* src = QKV + ((size_t)(8 + h) * M_TOK + tk) * 128 + chn * 8;
            pre[i] = *(const u32x4*)src; pre[4 + i] = *(const u32x4*)(src + (size_t)8 * M_TOK * 128);
        }
#pragma unroll
        for (int i = 0; i < 4; ++i) { const int c = tid + 512 * i, row = c >> 4, chn = c & 15; const unsigned o = off_b(row, chn);
            *(LAS u32x4*)(lds + o) = pre[i]; *(LAS u32x4*)(lds + 32768 + o) = pre[4 + i]; }
        __syncthreads();
        bf16x8 qf[4];
        { const size_t rq0 = tokbase + ((size_t)(n_start * 128 + 16 * w + fr) << dshift);
#pragma unroll
          for (int s = 0; s < 4; ++s) qf[s] = *(const bf16x8*)(QKV + ((size_t)h * M_TOK + rq0) * 128 + 32 * s + 8 * fq); }
        for (int bi = 0; bi < 4; ++bi) {
            const int n = n_start + bi;
            const unsigned cur = (unsigned)(bi & 1) * 65536u, prv = cur ^ 65536u;
            if (bi < 3) {
#pragma unroll
                for (int i = 0; i < 4; ++i) {
                    const int c = tid + 512 * i, row = c >> 4, chn = c & 15;
                    const size_t tk = tokbase + ((size_t)((n + 1) * 128 + row) << dshift);
                    const bf16_t* src = QKV + ((size_t)(8 + h) * M_TOK + tk) * 128 + chn * 8;
                    pre[i] = *(const u32x4*)src; pre[4 + i] = *(const u32x4*)(src + (size_t)8 * M_TOK * 128);
                }
            }
            __builtin_amdgcn_sched_barrier(0);
            int ln_ = lane; asm volatile("" : "+v"(ln_));
            const int fr = ln_ & 15, fq = ln_ >> 4;
            const int iq = 16 * w + fr;
            const size_t rowq = tokbase + ((size_t)(n * 128 + iq) << dshift);
            const int kb0 = w >> 1;
            const LAS float* tb = bt + (fr & 3) * 256 + (160 - (iq + 128 - 32 * kb0 - 8 * fq) + (fr & 3));
            f32x4 sacc[5][2];
            float mx = -1e30f;
            bf16x8 kf[2][4]; f32x4 bvv[2], bvn[2];
#define ATT_LOADK(kk_) do { const int kb_ = kb0 + (kk_); const unsigned slot_ = (kb_ >> 2) ? cur : prv; const int ksub_ = kb_ & 3; \
                _Pragma("unroll") for (int T = 0; T < 2; ++T) { const unsigned kr_ = 32 * ksub_ + 8 * (fr >> 2) + 4 * T + (fr & 3); \
                    _Pragma("unroll") for (int s = 0; s < 4; ++s) kf[T][s] = *(const LAS bf16x8*)(lds + slot_ + off_b(kr_, 4 * s + fq)); } \
                bvn[0] = *(const LAS f32x4*)(tb + 32 * (kk_)); bvn[1] = *(const LAS f32x4*)(tb + 32 * (kk_) + 4); } while (0)
            ATT_LOADK(0);
#pragma unroll
            for (int kk = 0; kk < 5; ++kk) {
                const int kb = kb0 + kk;
                __builtin_amdgcn_sched_barrier(0);
                f32x4 a0 = (f32x4){0.f, 0.f, 0.f, 0.f}, a1 = a0;
#pragma unroll
                for (int s = 0; s < 4; ++s) {
                    a0 = __builtin_amdgcn_mfma_f32_16x16x32_bf16(kf[0][s], qf[s], a0, 0, 0, 0);
                    a1 = __builtin_amdgcn_mfma_f32_16x16x32_bf16(kf[1][s], qf[s], a1, 0, 0, 0);
                }
                bvv[0] = bvn[0]; bvv[1] = bvn[1];
                __builtin_amdgcn_sched_barrier(0);
                if (kk < 4) ATT_LOADK(kk + 1);
                __builtin_amdgcn_sched_barrier(0);
                const bool dead = (n == 0) && (kb < 4);
#pragma unroll
                for (int j = 0; j < 4; ++j) {
                    const float l0 = dead ? -1e30f : a0[j] * sc2 + bvv[0][j];
                    const float l1 = dead ? -1e30f : a1[j] * sc2 + bvv[1][j];
                    a0[j] = l0; a1[j] = l1; mx = fmaxf(mx, fmaxf(l0, l1));
                }
                sacc[kk][0] = a0; sacc[kk][1] = a1;
            }
#undef ATT_LOADK
            mx = fmaxf(mx, __shfl_xor(mx, 16)); mx = fmaxf(mx, __shfl_xor(mx, 32));
            float psum = 0.f;
            bf16x8 pf[5];
#pragma unroll
            for (int kk = 0; kk < 5; ++kk) {
                float pv[8];
#pragma unroll
                for (int T = 0; T < 2; ++T)
#pragma unroll
                    for (int j = 0; j < 4; ++j) { const float e = __builtin_amdgcn_exp2f(sacc[kk][T][j] - mx); pv[4 * T + j] = e; psum += e; }
                u32x4 pw; pw.x = pk2(pv[0], pv[1]); pw.y = pk2(pv[2], pv[3]); pw.z = pk2(pv[4], pv[5]); pw.w = pk2(pv[6], pv[7]);
                pf[kk] = __builtin_bit_cast(bf16x8, pw);
            }
            psum += __shfl_xor(psum, 16); psum += __shfl_xor(psum, 32);
            __builtin_amdgcn_sched_barrier(0);
            if (bi < 3) {
                const size_t rqn = tokbase + ((size_t)((n + 1) * 128 + iq) << dshift);
#pragma unroll
                for (int s = 0; s < 4; ++s) qf[s] = *(const bf16x8*)(QKV + ((size_t)h * M_TOK + rqn) * 128 + 32 * s + 8 * fq);
            }
            bf16_t* orow = OB + ((size_t)(2 * h) * M_TOK + rowq) * 64 + 4 * fq;
            u32x2 oprev[8]; float lp = 0.f;
            if (g > 0) {
                lp = LSE[rowq * 8 + h];
#pragma unroll
                for (int c = 0; c < 8; ++c) oprev[c] = *(const u32x2*)(orow + (size_t)(c >> 2) * M_TOK * 64 + 16 * (c & 3));
            }
            __builtin_amdgcn_sched_barrier(0);
            f32x4 oacc[8];
#pragma unroll
            for (int c = 0; c < 8; ++c) oacc[c] = (f32x4){0.f, 0.f, 0.f, 0.f};
#pragma unroll
            for (int kk = 0; kk < 5; ++kk) {
                const int kb = kb0 + kk; const unsigned slot = ((kb >> 2) ? cur : prv) + 32768u; const int ksub = kb & 3;
                bf16x4 vlo[8], vhi[8];
#pragma unroll
                for (int c = 0; c < 8; ++c) {
                    vlo[c] = __builtin_amdgcn_ds_read_tr16_b64_v4i16((LAS bf16x4*)(lds + slot + tr_addr16(lane, c, ksub, 0)));
                    vhi[c] = __builtin_amdgcn_ds_read_tr16_b64_v4i16((LAS bf16x4*)(lds + slot + tr_addr16(lane, c, ksub, 1)));
                }
                __builtin_amdgcn_sched_barrier(0);
#pragma unroll
                for (int c = 0; c < 8; ++c) {
                    bf16x8 vf; vf[0] = vlo[c][0]; vf[1] = vlo[c][1]; vf[2] = vlo[c][2]; vf[3] = vlo[c][3]; vf[4] = vhi[c][0]; vf[5] = vhi[c][1]; vf[6] = vhi[c][2]; vf[7] = vhi[c][3];
                    oacc[c] = __builtin_amdgcn_mfma_f32_16x16x32_bf16(vf, pf[kk], oacc[c], 0, 0, 0);
                }
                __builtin_amdgcn_sched_barrier(0);
            }
            const float inv = __builtin_amdgcn_rcpf(psum);
            float lse2 = mx + __builtin_amdgcn_logf(psum);
            float wc_ = inv, wp_ = 0.f;
            if (g > 0) {
                const float mN = fmaxf(lp, lse2);
                const float ep = __builtin_amdgcn_exp2f(lp - mN), ec = __builtin_amdgcn_exp2f(lse2 - mN);
                const float den = ep + ec, rden = __builtin_amdgcn_rcpf(den);
                wp_ = ep * rden; wc_ = ec * rden * inv;
                lse2 = mN + __builtin_amdgcn_logf(den);
            }
#pragma unroll
            for (int c = 0; c < 8; ++c) {
                f32x4 o = oacc[c] * wc_;
                if (g > 0) { const u32x2 pw = oprev[c]; o[0] += wp_ * bflo(pw.x); o[1] += wp_ * bfhi(pw.x); o[2] += wp_ * bflo(pw.y); o[3] += wp_ * bfhi(pw.y); }
                u32x2 ow; ow.x = pk2(o[0], o[1]); ow.y = pk2(o[2], o[3]);
                *(u32x2*)(orow + (size_t)(c >> 2) * M_TOK * 64 + 16 * (c & 3)) = ow;
            }
            if (g < 2 && fq == 0) LSE[rowq * 8 + h] = lse2;
            __syncthreads();
            if (bi < 3) {
#pragma unroll
                for (int i = 0; i < 4; ++i) { const int c = tid + 512 * i, row = c >> 4, chn = c & 15; const unsigned o = off_b(row, chn);
                    *(LAS u32x4*)(lds + prv + o) = pre[i]; *(LAS u32x4*)(lds + prv + 32768 + o) = pre[4 + i]; }
            }
            __syncthreads();
        }
    }
}


#define XB_TMO      128
#define XB_XCNT(j)  (256  + 64 * (j))
#define XB_XSUB(j)  (1280 + 64 * (j))
#define XB_XGEN(j)  (2304 + 64 * (j))
#define XB_TOP      3328
#define XB_TOPGEN   3392
#define XCD_BAR_WORDS 3456
#define XB_SPIN_CAP (1u << 22)
__device__ __forceinline__ unsigned xb_ld(unsigned* p)              { return __hip_atomic_load(p, __ATOMIC_RELAXED, __HIP_MEMORY_SCOPE_AGENT); }
__device__ __forceinline__ unsigned xb_add(unsigned* p, unsigned v) { return __hip_atomic_fetch_add(p, v, __ATOMIC_RELAXED, __HIP_MEMORY_SCOPE_AGENT); }
__device__ __forceinline__ unsigned xb_xcc_id() { return (unsigned)__builtin_amdgcn_s_getreg((3 << 11) | 20) & 0xFu; }
#define XB_SPIN(cond, bar) do { unsigned _sp = 0; while (cond) { __builtin_amdgcn_s_sleep(1); \
    if ((++_sp & 255u) == 0u) { if (xb_ld(&(bar)[XB_TMO])) break; if (_sp > XB_SPIN_CAP) { atomicAdd(&(bar)[XB_TMO], 1u); break; } } } } while (0)
struct XcdBarrier { unsigned* bar; unsigned x; volatile LAS unsigned* st; };
__device__ __forceinline__ XcdBarrier xcd_barrier_post(unsigned* bar, volatile LAS unsigned* st) {
    XcdBarrier b; b.bar = bar; b.x = xb_xcc_id(); b.st = st;
    if (threadIdx.x == 0) (void)xb_add(&bar[XB_XCNT(b.x)], 1u);
    return b;
}
__device__ __forceinline__ void xcd_barrier_complete(unsigned* bar, unsigned x, unsigned& nloc, unsigned& nx) {
    const unsigned G = gridDim.x * gridDim.y * gridDim.z;
    unsigned sum, cnt, mine, sp = 0u;
    for (;;) {
        sum = 0u; cnt = 0u; mine = 0u;
#pragma unroll
        for (unsigned j = 0; j < 16; ++j) { const unsigned c = xb_ld(&bar[XB_XCNT(j)]); sum += c; cnt += (c > 0u) ? 1u : 0u; mine = (j == x) ? c : mine; }
        if (sum == G) break;
        __builtin_amdgcn_s_sleep(1);
        if ((++sp & 255u) == 0u) { if (xb_ld(&bar[XB_TMO])) break; if (sp > XB_SPIN_CAP) { atomicAdd(&bar[XB_TMO], 1u); break; } }
    }
    nloc = mine > 0u ? mine : 1u; nx = cnt > 0u ? cnt : 1u;
}
__device__ __forceinline__ void xcd_barrier(const XcdBarrier& b) {
    asm volatile("s_waitcnt vmcnt(0)" ::: "memory");
    __syncthreads();
    if (threadIdx.x == 0) {
        unsigned* bar = b.bar;
        __builtin_amdgcn_s_waitcnt(0);
        unsigned nloc = b.st[0], nx = b.st[1];
        if (nloc == 0u) { xcd_barrier_complete(bar, b.x, nloc, nx); b.st[0] = nloc; b.st[1] = nx; }
        const unsigned old = xb_add(&bar[XB_XSUB(b.x)], 1u);
        const unsigned gen = old / nloc;
        if (old + 1u == (gen + 1u) * nloc) {
            __builtin_amdgcn_fence(__ATOMIC_RELEASE, "agent");
            asm volatile("s_waitcnt vmcnt(0)" ::: "memory");
            const unsigned og = xb_add(&bar[XB_TOP], 1u);
            const unsigned tg = og / nx;
            if (og + 1u == (tg + 1u) * nx) xb_add(&bar[XB_TOPGEN], 1u);
            else XB_SPIN(xb_ld(&bar[XB_TOPGEN]) == tg, bar);
            __builtin_amdgcn_fence(__ATOMIC_ACQUIRE, "agent");
            xb_add(&bar[XB_XGEN(b.x)], 1u);
            asm volatile("s_waitcnt vmcnt(0)" ::: "memory");
        } else {
            XB_SPIN(xb_ld(&bar[XB_XGEN(b.x)]) == gen, bar);
            __builtin_amdgcn_fence(__ATOMIC_ACQUIRE, "agent");
            asm volatile("s_waitcnt vmcnt(0)" ::: "memory");
        }
    }
    __syncthreads();
}

__global__ void __launch_bounds__(512, 2) fwd_megakernel(Params p) {
    extern __shared__ __attribute__((aligned(16))) unsigned char lds_raw[];
    LAS unsigned char* lds = (LAS unsigned char*)lds_raw;
    cg::grid_group grid = cg::this_grid();
    const int wave = __builtin_amdgcn_readfirstlane((int)threadIdx.x >> 6);
    const int G = gridDim.x, gw = blockIdx.x * 8 + wave, NGW = G * 8;
    unsigned char* ws0 = p.ws;
    StaticOrder S;
    volatile LAS unsigned* bst = (volatile LAS unsigned*)(lds + MISC_OFF + 2048);
    if (threadIdx.x < 4) bst[threadIdx.x] = 0u;
    __syncthreads();
    const XcdBarrier xbar = xcd_barrier_post((unsigned*)(ws0 + WS_BAR), bst);

    prologue(p, lds, gw, NGW, wave);
    grid.sync();

    for (int layer = 0; layer < 4; ++layer) {
        const int j = layer >> 1;
        const bool even = (layer & 1) == 0;
        const int nst = even ? 9 : 6;
        for (int si = 0; si < nst; ++si) {
            const int code = even ? si : (si < 3 ? 9 + si : si + 3);
            unsigned char* ws = ws0; asm volatile("" : "+s"(ws));
            bf16_t* XB = (bf16_t*)(ws + WS_XB); float* P2 = (float*)(ws + WS_P2); float* LSE = (float*)(ws + WS_LSE);
            float* CEP = (float*)(ws + WS_CEP); float* CEH = (float*)(ws + WS_CEH);
            bf16_t* ACT0 = (bf16_t*)(ws + WS_ACT); bf16_t* ACT1 = (bf16_t*)(ws + WS_ACT + 64 * MiB); bf16_t* ACT2 = (bf16_t*)(ws + WS_ACT + 128 * MiB); bf16_t* ACT3 = (bf16_t*)(ws + WS_ACT + 192 * MiB);
            if (code == 0 || code == 2 || code == 4) {
                const int g = code >> 1;
                Gemm gm{XB, (const bf16_t*)(ws + WS_WQKV) + ((size_t)j * 9216 + (size_t)g * 3072) * 1024, 1024, 1024, 1024, 128, 12, 0, 0, 1, 128, 128};
                S.init(128, 12, G, blockIdx.x);
                EpiScale E{ACT0, 3072, P2};
                gemm_phase<EpiScale>(lds, gm, S, E);
            } else if (code == 1 || code == 3 || code == 5) {
                attn_phase(p, lds, ACT0, ACT3, LSE, code >> 1);
            } else if (code == 6 || code == 8) {
                Gemm gm;
                if (code == 6) {
                    if (even) gm = Gemm{ACT3, (const bf16_t*)(ws + WS_WO) + (size_t)j * 1024 * 1024, 64, 1024, 1024, 128, 4, 0, 0, 1, M_TOK * 128, 128};
                    else      gm = Gemm{ACT0, (const bf16_t*)(ws + WS_WOUT) + (size_t)j * 1024 * 1024, 1024, 1024, 1024, 128, 4, 0, 0, 1, 128, 128};
                } else        gm = Gemm{ACT0, (const bf16_t*)(ws + WS_WDN) + (size_t)layer * 1024 * 3072, 64, 64, 3072, 128, 4, 0, 0, 1, M_TOK * 128, 1024 * 128};
                S.init(128, 4, G, blockIdx.x);
                EpiRes E{XB, P2, (unsigned long long*)(ws + WS_GRAN), (code == 6 ? p.in[2] : p.in[4]) + layer * 1024, (layer == 3 && code == 8) ? p.out : nullptr,
                         (unsigned)(layer * 2 + (code == 8 ? 1 : 0) + 1), (LAS float*)(lds + MISC_OFF + 4096), (LAS float*)(lds + MISC_OFF + 8192)};
                gemm_phase<EpiRes>(lds, gm, S, E);
            } else if (code == 7) {
                Gemm gm{XB, (const bf16_t*)(ws + WS_WUP) + (size_t)layer * 6144 * 1024, 1024, 1024, 1024, 130, 24, 1, 126, 65, 128, 128};
                S.init(130, 24, G, blockIdx.x);
                EpiUp E{ACT0, P2, p.in[18] + (size_t)layer * 3 * 6144, p.in[19] + (size_t)layer * 6144};
                gemm_phase<EpiUp>(lds, gm, S, E);
            } else if (code == 9) {
                Gemm gm{XB, (const bf16_t*)(ws + WS_WIN) + (size_t)j * 2048 * 1024, 1024, 1024, 1024, 132, 8, 1, 125, 66, 128, 128};
                S.init(132, 8, G, blockIdx.x);
                EpiIn E{ACT0, ACT1, P2, p.in[9] + (size_t)j * 4 * 1024, p.in[10] + (size_t)j * 1024};
                gemm_phase<EpiIn>(lds, gm, S, E);
            } else if (code == 10) {
                Gemm gm{ACT0, (const bf16_t*)(ws + WS_WG) + (size_t)j * 4 * 512 * 256, 1024, 256, 256, 128, 8, 2, 128, 64, 128, 128};
                S.init(128, 8, G, blockIdx.x);
                EpiGate E{ACT0, ACT2, ACT3, CEP, CEH, p.in[12] + (size_t)j * 1024, p.in[14] + (size_t)j * 1024, p.in[15] + (size_t)j * 1024};
                gemm_phase<EpiGate>(lds, gm, S, E);
            } else {
                lru_apply(ACT2, ACT3, ACT1, ACT0, CEP, CEH);
            }
            if (!(layer == 3 && si == nst - 1)) xcd_barrier(xbar);
        }
    }
}

static int t5_bucket_host(int dist) {
    const int max_exact = 16;
    if (dist < max_exact) return dist;
    const double d = (double)(dist < 1 ? 1 : dist);
    int large = max_exact + (int)(std::log(d / max_exact) / std::log(2048.0 / max_exact) * (32 - max_exact));
    return large < 31 ? large : 31;
}

extern "C" void kernel_launch(void* const* d_in, const int* in_sizes, int n_in, void* d_out, int out_size, void* d_ws, size_t ws_size, hipStream_t stream) {
    if (n_in != 21 || out_size != M_TOK * DM || ws_size < WS_END) { fprintf(stderr, "kernel_launch: unexpected shapes (n_in %d out %d ws %zu need %zu)\n", n_in, out_size, ws_size, (size_t)WS_END); return; }
    static int grid_blocks = 0;
    if (!grid_blocks) {
        int dev = 0, cus = 0, per_cu = 0;
        hipGetDevice(&dev);
        hipDeviceGetAttribute(&cus, hipDeviceAttributeMultiprocessorCount, dev);
        hipFuncSetAttribute((const void*)fwd_megakernel, hipFuncAttributeMaxDynamicSharedMemorySize, LDS_BYTES);
        hipOccupancyMaxActiveBlocksPerMultiprocessor(&per_cu, (const void*)fwd_megakernel, 512, LDS_BYTES);
        if (per_cu < 1) per_cu = 1;
        grid_blocks = cus * per_cu;
        if (grid_blocks > 256) grid_blocks = 256;
    }
    if (grid_blocks != 256) { fprintf(stderr, "kernel_launch: needs a 256-workgroup cooperative grid (got %d)\n", grid_blocks); return; }
    Params p; memset(&p, 0, sizeof(p));
    for (int i = 0; i < 21; ++i) p.in[i] = (const float*)d_in[i];
    p.out = (float*)d_out; p.ws = (unsigned char*)d_ws;
    const int dil[3] = {1, 4, 16};
    for (int g = 0; g < 3; ++g) for (int m = 0; m <= 128; ++m) p.bucket[g * 136 + m] = (unsigned char)t5_bucket_host(m * dil[g]);
    (void)hipMemsetAsync((unsigned char*)d_ws + WS_BAR, 0, 16384, stream);
    void* args[] = {&p};
    hipError_t e = hipLaunchCooperativeKernel((const void*)fwd_megakernel, dim3(grid_blocks), dim3(512), args, LDS_BYTES, stream);
    if (e != hipSuccess) fprintf(stderr, "cooperative launch failed: %s (grid %d)\n", hipGetErrorString(e), grid_blocks);
}
```

```cpp
#include <hip/hip_runtime.h>
#include <hip/hip_cooperative_groups.h>
#include <cstdio>
#include <cmath>
#include <cstring>
namespace cg = cooperative_groups;

#define LAS __attribute__((address_space(3)))
typedef unsigned short bf16_t;
typedef short bf16x8 __attribute__((ext_vector_type(8)));
typedef short bf16x4 __attribute__((ext_vector_type(4)));
typedef float f32x4 __attribute__((ext_vector_type(4)));
typedef unsigned u32x4 __attribute__((ext_vector_type(4)));
typedef unsigned u32x2 __attribute__((ext_vector_type(2)));

constexpr int M_TOK = 32768, DM = 1024, SEQ = 8192;
constexpr float RMS_EPS = 1e-6f;
constexpr float LOG2E = 1.4426950408889634f;

__device__ __forceinline__ unsigned pk2(float lo, float hi) { unsigned r; asm("v_cvt_pk_bf16_f32 %0, %1, %2" : "=v"(r) : "v"(lo), "v"(hi)); return r; }
__device__ __forceinline__ float bflo(unsigned w) { return __uint_as_float(w << 16); }
__device__ __forceinline__ float bfhi(unsigned w) { return __uint_as_float(w & 0xffff0000u); }
__device__ __forceinline__ float gelu_tanh(float x) {
    const float inner = x + 0.044715f * x * x * x;
    const float e = __builtin_amdgcn_exp2f(-2.0f * 0.7978845608028654f * LOG2E * inner);
    return x * __builtin_amdgcn_rcpf(1.0f + e);
}
__device__ __forceinline__ f32x4 gelu_mul4(const f32x4 x, const f32x4 v) {
    constexpr float K0 = -2.0f * 0.7978845608028654f * LOG2E, K1 = K0 * 0.044715f;
    const f32x4 t = ((x * x) * K1 + K0) * x;
    f32x4 e; e[0] = __builtin_amdgcn_exp2f(t[0]); e[1] = __builtin_amdgcn_exp2f(t[1]); e[2] = __builtin_amdgcn_exp2f(t[2]); e[3] = __builtin_amdgcn_exp2f(t[3]);
    const f32x4 d = e + 1.0f;
    f32x4 r; r[0] = __builtin_amdgcn_rcpf(d[0]); r[1] = __builtin_amdgcn_rcpf(d[1]); r[2] = __builtin_amdgcn_rcpf(d[2]); r[3] = __builtin_amdgcn_rcpf(d[3]);
    return (x * v) * r;
}
__device__ __forceinline__ float sigmoidf_(float x) { return __builtin_amdgcn_rcpf(1.0f + __builtin_amdgcn_exp2f(-LOG2E * x)); }
__device__ __forceinline__ float wave_sum(float v) {
#pragma unroll
    for (int o = 1; o < 64; o <<= 1) v += __shfl_xor(v, o);
    return v;
}
__device__ __forceinline__ f32x4 shfl_up4(f32x4 v, int d) { f32x4 r; r[0] = __shfl_up(v[0], d, 16); r[1] = __shfl_up(v[1], d, 16); r[2] = __shfl_up(v[2], d, 16); r[3] = __shfl_up(v[3], d, 16); return r; }

constexpr int BM = 256, BK = 64, HALF = 128, HTB = HALF * BK * 2, STAGE_BYTES = 8 * HTB, NXCD = 8, WGM = 8;
__device__ __forceinline__ int lds_byte(int r, int c) { const int st = (r >> 4) * 2 + (c >> 5), rr = r & 15, cc = c & 31, ob = rr * 64 + cc * 2; return st * 1024 + (ob ^ (((ob >> 9) & 1) << 5)); }
__device__ __forceinline__ void stage_rc(int b, int& R, int& C) { const int st = b / 1024, sb = b % 1024, swz = sb ^ (((sb >> 9) & 1) << 5); R = (st >> 1) * 16 + swz / 64; C = (st & 1) * 32 + (swz % 64) / 2; }
__device__ __forceinline__ int perm32(int rho) { const int n = rho >> 4, i = rho & 15; return 8 * (i >> 2) + 4 * n + (i & 3); }

struct Unit { int pm, pn; };
struct Gemm { const bf16_t* A; const bf16_t* Bt; int lda, ldb, K, nM, nN, mode, stride, spb, ksA, ksB; };
struct StaticOrder {
    int nM, nN, nwg, G, c;
    __device__ void init(int nM_, int nN_, int G_, int c_) { nM = nM_; nN = nN_; nwg = nM * nN; G = G_; c = c_; }
    __device__ bool next(int i, Unit& u) const {
        const long L = (long)i * G + c; if (L >= nwg) return false;
        int wgid = (int)L; { const int q = nwg / NXCD, r = nwg % NXCD, xcd = wgid % NXCD, off = wgid / NXCD; wgid = (xcd < r ? xcd * (q + 1) : r * (q + 1) + (xcd - r) * q) + off; }
        const int nig = WGM * nN, gid = wgid / nig, fm = gid * WGM, gsz = (nM - fm) < WGM ? (nM - fm) : WGM;
        u.pm = fm + ((wgid % nig) % gsz); u.pn = (wgid % nig) / gsz; return true;
    }
};
__device__ __forceinline__ unsigned a_voff(const Gemm& g, const Unit& u, int piece, int R, int C) {
    int row, col = C;
    if (g.mode == 0) row = u.pm * 256 + R;
    else { const int sg = 2 * u.pm + piece, b = sg / g.spb, s = sg - b * g.spb; row = b * SEQ + g.stride * s + (R & 15) * 8 + ((R >> 4) & 3); if (g.mode == 2) col += (u.pn >> 1) * 256; }
    return (unsigned)(row * g.lda + col) * 2u;
}

typedef f32x4 Acc[2][2][4][2];
__device__ __forceinline__ float rstd_from_parts(const f32x4 p) { return 1.0f / sqrtf(((p[0] + p[1]) + (p[2] + p[3])) * (1.0f / 1024.0f) + 1e-6f); }
constexpr int PRM_OFF = 8 * 128 * 64 * 2 + 12288;
constexpr int PRM_STRIDE = 10240;
__device__ __forceinline__ void rstd_to_lds(LAS unsigned char* prm) {
    int t_ = threadIdx.x; asm volatile("" : "+v"(t_));
    if (t_ < 256) ((LAS float*)prm)[2304 + t_] = rstd_from_parts(((const LAS f32x4*)prm)[t_]);
    asm volatile("s_waitcnt lgkmcnt(0)" ::: "memory"); __builtin_amdgcn_s_barrier(); asm volatile("" ::: "memory");
}


__device__ __forceinline__ size_t a_piece_delta(const Gemm& g, const Unit& u) {
    if (g.mode == 0) return (size_t)64 * g.lda * 2;
    const int s0 = 2 * u.pm, s1 = s0 + 1, b0 = s0 / g.spb, b1 = s1 / g.spb;
    const int r0 = b0 * SEQ + g.stride * (s0 - b0 * g.spb), r1 = b1 * SEQ + g.stride * (s1 - b1 * g.spb);
    return (size_t)(r1 - r0) * g.lda * 2;
}
template <class Epi>
__device__ __forceinline__ void gemm_phase(LAS unsigned char* lds, const Gemm g, const StaticOrder& S, const Epi& E) {
    int tid_ = threadIdx.x; asm volatile("" : "+v"(tid_));
    const int tid = tid_, wid = __builtin_amdgcn_readfirstlane(tid >> 6), lane = tid & 63, wr = wid >> 2, wc = wid & 3, fr = lane & 15, fq = lane >> 4;
    int K_ = g.K; asm volatile("" : "+s"(K_));
    const int K = K_, nt = K / BK;
    int R0, C0; stage_rc(tid * 16, R0, C0);
    const unsigned voffB = (unsigned)(((R0 & ~31) + perm32(R0 & 31)) * g.ldb + C0) * 2u;
    const size_t dB = (size_t)64 * g.ldb * 2;
    const size_t kstepA = Epi::RT_KSTEP ? (size_t)g.ksA : (size_t)128, kstepB = Epi::RT_KSTEP ? (size_t)g.ksB : (size_t)128;
    const size_t hstepA = (g.mode == 0) ? (size_t)HALF * g.lda * 2 : (size_t)4 * g.lda * 2;
    const size_t hstepB = (size_t)HALF * g.ldb * 2;
    const size_t tstepB = 2 * hstepB;
    const unsigned ldsw = (unsigned)wid * 1024u;
    const int aoff = lds_byte(wr * 64 + fr, fq * 8), boff = lds_byte(wc * 32 + fr, fq * 8);
#define PG8_SA(b, h) (((b) * 2 + (h)) * HTB)
#define PG8_SB(b, h) ((4 + (b) * 2 + (h)) * HTB)
#define PG8_STG(bufoff, gbase, o, d) do { \
        __builtin_amdgcn_global_load_lds((const unsigned*)((const char*)(gbase) + (o)), (LAS unsigned*)(lds + (bufoff) + ldsw), 16, 0, 0); \
        __builtin_amdgcn_global_load_lds((const unsigned*)((const char*)(gbase) + (d) + (o)), (LAS unsigned*)(lds + (bufoff) + ldsw + 8192), 16, 0, 0); } while (0)
#define PG8_LDA(dst, b, h) do { _Pragma("unroll") for (int m = 0; m < 4; ++m) _Pragma("unroll") for (int k = 0; k < 2; ++k) dst[m][k] = *(const LAS bf16x8*)(lds + PG8_SA(b, h) + aoff + m * 2048 + k * 1024); } while (0)
#define PG8_LDB(dst, b, h) do { _Pragma("unroll") for (int n = 0; n < 2; ++n) _Pragma("unroll") for (int k = 0; k < 2; ++k) dst[n][k] = *(const LAS bf16x8*)(lds + PG8_SB(b, h) + boff + n * 2048 + k * 1024); } while (0)
#define PG8_MMA(ai, bj, At, Bt) do { __builtin_amdgcn_s_setprio(1); _Pragma("unroll") for (int m = 0; m < 4; ++m) _Pragma("unroll") for (int n = 0; n < 2; ++n) _Pragma("unroll") for (int k = 0; k < 2; ++k) \
        acc[ai][bj][m][n] = __builtin_amdgcn_mfma_f32_16x16x32_bf16(Bt[n][k], At[m][k], acc[ai][bj][m][n], 0, 0, 0); __builtin_amdgcn_s_setprio(0); } while (0)
#define PG8_MMAZ(ai, bj, At, Bt) do { __builtin_amdgcn_s_setprio(1); _Pragma("unroll") for (int m = 0; m < 4; ++m) _Pragma("unroll") for (int n = 0; n < 2; ++n) { \
        acc[ai][bj][m][n] = __builtin_amdgcn_mfma_f32_16x16x32_bf16(Bt[n][0], At[m][0], (f32x4){0.f, 0.f, 0.f, 0.f}, 0, 0, 0); \
        acc[ai][bj][m][n] = __builtin_amdgcn_mfma_f32_16x16x32_bf16(Bt[n][1], At[m][1], acc[ai][bj][m][n], 0, 0, 0); } __builtin_amdgcn_s_setprio(0); } while (0)
#define PG8_WAIT_V(n) asm volatile("s_waitcnt vmcnt(" #n ")" ::: "memory")
#define PG8_WAIT_L(n) asm volatile("s_waitcnt lgkmcnt(" #n ")" ::: "memory")
#define PG8_BAR __builtin_amdgcn_s_barrier()
#define PG8_SCHED __builtin_amdgcn_sched_barrier(0)
    Unit cur, nxt; int ui = 0;
    if (!S.next(0, cur)) return;
    Acc acc;
    if constexpr (!Epi::PEEL) {
#pragma unroll
        for (int a = 0; a < 2; ++a)
#pragma unroll
            for (int b = 0; b < 2; ++b)
#pragma unroll
                for (int m = 0; m < 4; ++m)
#pragma unroll
                    for (int n = 0; n < 2; ++n) acc[a][b][m][n] = (f32x4){0.f, 0.f, 0.f, 0.f};
    }
    bf16x8 At[4][2], B0[2][2], B1[2][2];
    const char* const Ab = (const char*)g.A;
    unsigned vA0 = a_voff(g, cur, 0, R0, C0); size_t dC = a_piece_delta(g, cur);
    const char* cB = (const char*)g.Bt + (size_t)cur.pn * tstepB;
    PG8_STG(PG8_SB(0, 0), cB, voffB, dB); PG8_STG(PG8_SB(0, 1), cB + hstepB, voffB, dB); PG8_STG(PG8_SA(0, 0), Ab, vA0, dC); PG8_STG(PG8_SA(0, 1), Ab + hstepA, vA0, dC);
    if (wr == 1) PG8_BAR;
    PG8_WAIT_V(2); PG8_BAR;
    PG8_STG(PG8_SB(1, 0), cB + kstepB, voffB, dB); PG8_STG(PG8_SA(1, 0), Ab + kstepA, vA0, dC); PG8_STG(PG8_SB(1, 1), cB + hstepB + kstepB, voffB, dB);
    PG8_WAIT_V(6); PG8_BAR;
    for (;;) {
        const bool has_next = S.next(ui + 1, nxt);
        unsigned vN0 = vA0; size_t dN = dC;
        if (has_next) { int t2 = threadIdx.x; asm volatile("" : "+v"(t2)); int r0, c0; stage_rc(t2 * 16, r0, c0); vN0 = a_voff(g, nxt, 0, r0, c0); dN = a_piece_delta(g, nxt); }
        const char* nB = has_next ? (const char*)g.Bt + (size_t)nxt.pn * tstepB : cB;
        E.prefetch(lds + PRM_OFF + (ui & 1) * PRM_STRIDE, cur, wid);
        if constexpr (Epi::PEEL)
        {
            const int t = 0;
            const bool last = false;
            const char* a1 = Ab + (size_t)(t + 1) * kstepA;
            const char* a2 = last ? Ab : Ab + (size_t)(t + 2) * kstepA; const char* b2 = last ? nB : cB + (size_t)(t + 2) * kstepB;
            const char* a3 = a2 + kstepA; const char* b3 = b2 + kstepB;
            const unsigned w0 = last ? vN0 : vA0; const size_t dW = last ? dN : dC;
            PG8_LDB(B0, 0, 0); PG8_LDB(B1, 0, 1); PG8_SCHED; PG8_LDA(At, 0, 0); PG8_STG(PG8_SA(1, 1), a1 + hstepA, vA0, dC);
            PG8_WAIT_V(8); PG8_WAIT_L(0); PG8_BAR; PG8_MMAZ(0, 0, At, B0); PG8_MMAZ(0, 1, At, B1); PG8_BAR; PG8_SCHED;
            PG8_LDA(At, 0, 1); PG8_STG(PG8_SB(0, 0), b2, voffB, dB); PG8_STG(PG8_SB(0, 1), b2 + hstepB, voffB, dB); PG8_STG(PG8_SA(0, 0), a2, w0, dW);
            PG8_WAIT_V(8); PG8_WAIT_L(0); PG8_BAR; PG8_MMAZ(1, 0, At, B0); PG8_MMAZ(1, 1, At, B1); PG8_BAR; PG8_SCHED;
            PG8_LDB(B0, 1, 0); PG8_LDB(B1, 1, 1); PG8_SCHED; PG8_LDA(At, 1, 0); PG8_STG(PG8_SA(0, 1), a2 + hstepA, w0, dW);
            PG8_WAIT_V(8); PG8_WAIT_L(0); PG8_BAR; PG8_MMA(0, 0, At, B0); PG8_MMA(0, 1, At, B1); PG8_BAR; PG8_SCHED;
            PG8_LDA(At, 1, 1); PG8_STG(PG8_SB(1, 0), b3, voffB, dB); PG8_STG(PG8_SB(1, 1), b3 + hstepB, voffB, dB); PG8_STG(PG8_SA(1, 0), a3, w0, dW);
            PG8_WAIT_V(8); PG8_WAIT_L(0); PG8_BAR; PG8_MMA(1, 0, At, B0); PG8_MMA(1, 1, At, B1); PG8_BAR; PG8_SCHED;
        }
        for (int t = Epi::PEEL ? 2 : 0; t < nt; t += 2) {
            const bool last = (t == nt - 2);
            const char* a1 = Ab + (size_t)(t + 1) * kstepA;
            const char* a2 = last ? Ab : Ab + (size_t)(t + 2) * kstepA; const char* b2 = last ? nB : cB + (size_t)(t + 2) * kstepB;
            const char* a3 = a2 + kstepA; const char* b3 = b2 + kstepB;
            const unsigned w0 = last ? vN0 : vA0; const size_t dW = last ? dN : dC;
            PG8_LDB(B0, 0, 0); PG8_LDB(B1, 0, 1); PG8_SCHED; PG8_LDA(At, 0, 0); PG8_STG(PG8_SA(1, 1), a1 + hstepA, vA0, dC);
            PG8_WAIT_V(8); PG8_WAIT_L(0); PG8_BAR; PG8_MMA(0, 0, At, B0); PG8_MMA(0, 1, At, B1); PG8_BAR; PG8_SCHED;
            PG8_LDA(At, 0, 1); PG8_STG(PG8_SB(0, 0), b2, voffB, dB); PG8_STG(PG8_SB(0, 1), b2 + hstepB, voffB, dB); PG8_STG(PG8_SA(0, 0), a2, w0, dW);
            PG8_WAIT_V(8); PG8_WAIT_L(0); PG8_BAR; PG8_MMA(1, 0, At, B0); PG8_MMA(1, 1, At, B1); PG8_BAR; PG8_SCHED;
            PG8_LDB(B0, 1, 0); PG8_LDB(B1, 1, 1); PG8_SCHED; PG8_LDA(At, 1, 0); PG8_STG(PG8_SA(0, 1), a2 + hstepA, w0, dW);
            PG8_WAIT_V(8); PG8_WAIT_L(0); PG8_BAR; PG8_MMA(0, 0, At, B0); PG8_MMA(0, 1, At, B1); PG8_BAR; PG8_SCHED;
            PG8_LDA(At, 1, 1); PG8_STG(PG8_SB(1, 0), b3, voffB, dB); PG8_STG(PG8_SB(1, 1), b3 + hstepB, voffB, dB); PG8_STG(PG8_SA(1, 0), a3, w0, dW);
            PG8_WAIT_V(8); PG8_WAIT_L(0); PG8_BAR; PG8_MMA(1, 0, At, B0); PG8_MMA(1, 1, At, B1); PG8_BAR; PG8_SCHED;
        }
        if (wr == 0) PG8_BAR;
        E(acc, cur, wr, wc, fr, fq, lds + PRM_OFF + (ui & 1) * PRM_STRIDE);
        if (!has_next) break;
        if constexpr (!Epi::PEEL) {
#pragma unroll
            for (int a = 0; a < 2; ++a)
#pragma unroll
                for (int b = 0; b < 2; ++b)
#pragma unroll
                    for (int m = 0; m < 4; ++m)
#pragma unroll
                        for (int n = 0; n < 2; ++n) acc[a][b][m][n] = (f32x4){0.f, 0.f, 0.f, 0.f};
        }
        cur = nxt; cB = nB; vA0 = vN0; dC = dN; ++ui;
        if (wr == 1) PG8_BAR;
    }
    PG8_WAIT_V(0);
    PG8_BAR;
#undef PG8_SA
#undef PG8_SB
#undef PG8_STG
#undef PG8_LDA
#undef PG8_LDB
#undef PG8_MMA
#undef PG8_MMAZ
#undef PG8_WAIT_V
#undef PG8_WAIT_L
#undef PG8_BAR
#undef PG8_SCHED
}


__device__ __forceinline__ float row_rstd(const float* P2, int row) {
    const f32x4 p = *(const f32x4*)(P2 + (size_t)row * 4);
    return 1.0f / sqrtf(((p[0] + p[1]) + (p[2] + p[3])) * (1.0f / DM) + RMS_EPS);
}
struct EpiScale {
    static constexpr bool PEEL = true;
    static constexpr bool RT_KSTEP = false;
    bf16_t* O; int ldc; const float* rstd;
    __device__ __forceinline__ void prefetch(LAS unsigned char* prm, const Unit& u, int wid) const {
        if (wid < 4) { int t_ = threadIdx.x; asm volatile("" : "+v"(t_));
            __builtin_amdgcn_global_load_lds((const unsigned*)(rstd + (size_t)(u.pm * 256 + t_) * 4), (LAS unsigned*)(prm + wid * 1024), 16, 0, 0); }
    }
    __device__ __forceinline__ void operator()(Acc& acc, const Unit& u, int wr, int wc, int fr, int fq, LAS unsigned char* prm) const {
        { int t_ = threadIdx.x; asm volatile("" : "+v"(t_)); fr = t_ & 15; fq = (t_ >> 4) & 3; }
        const int row0 = u.pm * 256 + wr * 64 + fr, col0 = u.pn * 256 + wc * 32 + 8 * fq;
        rstd_to_lds(prm);
        float rsv[2][4];
#pragma unroll
        for (int ai = 0; ai < 2; ++ai)
#pragma unroll
            for (int m = 0; m < 4; ++m) rsv[ai][m] = ((const LAS float*)prm)[2304 + wr * 64 + fr + ai * 128 + m * 16];
#pragma unroll
        for (int ai = 0; ai < 2; ++ai)
#pragma unroll
            for (int m = 0; m < 4; ++m) {
                const int row = row0 + ai * 128 + m * 16;
                const float rs = rsv[ai][m];
                bf16_t* rowp = O + ((size_t)(2 * u.pn) * M_TOK + row) * 128 + wc * 32 + 8 * fq;
#pragma unroll
                for (int bj = 0; bj < 2; ++bj) {
                    const f32x4 v0 = acc[ai][bj][m][0] * rs, v1 = acc[ai][bj][m][1] * rs;
                    u32x4 w; w.x = pk2(v0[0], v0[1]); w.y = pk2(v0[2], v0[3]); w.z = pk2(v1[0], v1[1]); w.w = pk2(v1[2], v1[3]);
                    *(u32x4*)(rowp + (size_t)bj * M_TOK * 128) = w;
                }
            }
    }
};

struct EpiUp {
    static constexpr bool PEEL = false;
    static constexpr bool RT_KSTEP = false;
    bf16_t* O; const float* rstd; const float* cw; const float* cb;
    __device__ __forceinline__ void prefetch(LAS unsigned char* prm, const Unit& u, int wid) const {
        int t_ = threadIdx.x; asm volatile("" : "+v"(t_));
        if (wid < 4) { const int sg = 2 * u.pm + (t_ >> 7), b = sg / 65, s = sg - 65 * b;
            __builtin_amdgcn_global_load_lds((const unsigned*)(rstd + (size_t)(b * SEQ + 126 * s + (t_ & 127)) * 4), (LAS unsigned*)(prm + wid * 1024), 16, 0, 0); }
#pragma unroll
        for (int h = 0; h < 2; ++h) {
            const int idx = t_ + 512 * h, a = idx >> 7, c = idx & 127, k = a & 3, col = (a >> 2) * 3072 + 128 * u.pn + c;
            const float* src = (k < 3) ? (cw + k * 6144 + col) : (cb + col);
            __builtin_amdgcn_global_load_lds((const unsigned*)src, (LAS unsigned*)(prm + 4096 + (wid + 8 * h) * 256), 4, 0, 0);
        }
    }
    __device__ __forceinline__ void operator()(Acc& acc, const Unit& u, int wr, int wc, int fr, int fq, LAS unsigned char* prm) const {
        { int t_ = threadIdx.x; asm volatile("" : "+v"(t_)); fr = t_ & 15; fq = (t_ >> 4) & 3; }
        rstd_to_lds(prm);
        const int sg = 2 * u.pm + wr, b = sg / 65, s = sg - 65 * b;
        const int rowbase = b * SEQ + 126 * s + fr * 8;
#pragma unroll
        for (int ai = 0; ai < 2; ++ai)
#pragma unroll
            for (int m = 0; m < 4; ++m) {
                const float rs = ((const LAS float*)prm)[2304 + wr * 128 + fr * 8 + ai * 4 + m];
#pragma unroll
                for (int bj = 0; bj < 2; ++bj)
#pragma unroll
                    for (int n = 0; n < 2; ++n) acc[ai][bj][m][n] *= rs;
            }
        __builtin_amdgcn_sched_barrier(0);
        const int ch0 = 128 * u.pn + 32 * wc + 8 * fq;
#pragma unroll
        for (int n = 0; n < 2; ++n) {
            const int ch = ch0 + 4 * n;
            const LAS float* pw = (const LAS float*)prm + 1024 + 32 * wc + 8 * fq + 4 * n;
            const f32x4 g0 = *(const LAS f32x4*)(pw), g1 = *(const LAS f32x4*)(pw + 128), g2 = *(const LAS f32x4*)(pw + 256), gb = *(const LAS f32x4*)(pw + 384);
            const f32x4 v0 = *(const LAS f32x4*)(pw + 512), v1 = *(const LAS f32x4*)(pw + 640), v2 = *(const LAS f32x4*)(pw + 768), vb = *(const LAS f32x4*)(pw + 896);
            f32x4 pg1 = shfl_up4(acc[1][0][3][n], 1), pg2 = shfl_up4(acc[1][0][2][n], 1);
            f32x4 pv1 = shfl_up4(acc[1][1][3][n], 1), pv2 = shfl_up4(acc[1][1][2][n], 1);
            if (fr == 0) { pg1 = (f32x4){0.f, 0.f, 0.f, 0.f}; pg2 = pg1; pv1 = pg1; pv2 = pg1; }
#pragma unroll
            for (int ai = 0; ai < 2; ++ai)
#pragma unroll
                for (int m = 0; m < 4; ++m) {
                    const f32x4 yg = acc[ai][0][m][n], yv = acc[ai][1][m][n];
                    const f32x4 ug = gb + g0 * pg2 + g1 * pg1 + g2 * yg;
                    const f32x4 uv = vb + v0 * pv2 + v1 * pv1 + v2 * yv;
                    pg2 = pg1; pg1 = yg; pv2 = pv1; pv1 = yv;
                    acc[ai][0][m][n] = gelu_mul4(ug, uv);
                }
            __builtin_amdgcn_sched_barrier(0);
        }
        __builtin_amdgcn_sched_barrier(0);
        bf16_t* const obase = O + (size_t)(ch0 >> 6) * ((size_t)M_TOK * 64) + (size_t)rowbase * 64 + (ch0 & 63);
#pragma unroll
        for (int ai = 0; ai < 2; ++ai)
#pragma unroll
            for (int m = 0; m < 4; ++m) {
                const int jj = ai * 4 + m;
                if (s == 0 || fr * 8 + jj >= 2) {
                    const f32x4 a0 = acc[ai][0][m][0], a1 = acc[ai][0][m][1];
                    u32x4 w; w.x = pk2(a0[0], a0[1]); w.y = pk2(a0[2], a0[3]); w.z = pk2(a1[0], a1[1]); w.w = pk2(a1[2], a1[3]);
                    *(u32x4*)(obase + jj * 64) = w;
                }
            }
    }
};

struct EpiIn {
    static constexpr bool PEEL = false;
    static constexpr bool RT_KSTEP = false;
    __device__ __forceinline__ void prefetch(LAS unsigned char* prm, const Unit& u, int wid) const {
        int t_ = threadIdx.x; asm volatile("" : "+v"(t_));
        if (wid < 4) { const int sg = 2 * u.pm + (t_ >> 7), b = sg / 66, s = sg - 66 * b; int rr = b * SEQ + 125 * s + (t_ & 127); rr = rr < M_TOK ? rr : M_TOK - 1;
            __builtin_amdgcn_global_load_lds((const unsigned*)(rstd + (size_t)rr * 4), (LAS unsigned*)(prm + wid * 1024), 16, 0, 0); }
        if (u.pn < 4) {
#pragma unroll
            for (int h = 0; h < 2; ++h) {
                const int idx = t_ + 512 * h, k = idx >> 8, c = idx & 255;
                __builtin_amdgcn_global_load_lds((const unsigned*)(cw + k * 1024 + 256 * u.pn + c), (LAS unsigned*)(prm + 4096 + (wid + 8 * h) * 256), 4, 0, 0);
            }
            if (wid < 4) __builtin_amdgcn_global_load_lds((const unsigned*)(cb + 256 * u.pn + t_), (LAS unsigned*)(prm + 4096 + (wid + 16) * 256), 4, 0, 0);
        }
    }
    bf16_t* XC; bf16_t* GATE; const float* rstd; const float* cw; const float* cb;
    __device__ __forceinline__ void operator()(Acc& acc, const Unit& u, int wr, int wc, int fr, int fq, LAS unsigned char* prm) const {
        { int t_ = threadIdx.x; asm volatile("" : "+v"(t_)); fr = t_ & 15; fq = (t_ >> 4) & 3; }
        rstd_to_lds(prm);
        const int sg = 2 * u.pm + wr, b = sg / 66, s = sg - 66 * b;
        const int tl0 = 125 * s + fr * 8, rowbase = b * SEQ + tl0;
#pragma unroll
        for (int ai = 0; ai < 2; ++ai)
#pragma unroll
            for (int m = 0; m < 4; ++m) {
                int rr = rowbase + ai * 4 + m; rr = rr < M_TOK ? rr : M_TOK - 1;
                const float rs = ((const LAS float*)prm)[2304 + wr * 128 + fr * 8 + ai * 4 + m];
#pragma unroll
                for (int bj = 0; bj < 2; ++bj)
#pragma unroll
                    for (int n = 0; n < 2; ++n) acc[ai][bj][m][n] *= rs;
            }
        bf16_t* OUT; int colbase;
        if (u.pn < 4) {
            OUT = XC; colbase = 256 * u.pn + 32 * wc + 8 * fq;
#pragma unroll
            for (int bj = 0; bj < 2; ++bj)
#pragma unroll
                for (int n = 0; n < 2; ++n) {
                    const int ch = colbase + 128 * bj + 4 * n;
                    const LAS float* pw = (const LAS float*)prm + 1024 + 128 * bj + 32 * wc + 8 * fq + 4 * n;
                    const f32x4 w0 = *(const LAS f32x4*)(pw), w1 = *(const LAS f32x4*)(pw + 256), w2 = *(const LAS f32x4*)(pw + 512), w3 = *(const LAS f32x4*)(pw + 768), bb = *(const LAS f32x4*)(pw + 1024);
                    f32x4 p1 = shfl_up4(acc[1][bj][3][n], 1), p2 = shfl_up4(acc[1][bj][2][n], 1), p3 = shfl_up4(acc[1][bj][1][n], 1);
                    if (fr == 0) { p1 = (f32x4){0.f, 0.f, 0.f, 0.f}; p2 = p1; p3 = p1; }
#pragma unroll
                    for (int ai = 0; ai < 2; ++ai)
#pragma unroll
                        for (int m = 0; m < 4; ++m) {
                            const f32x4 y = acc[ai][bj][m][n];
                            acc[ai][bj][m][n] = bb + w0 * p3 + w1 * p2 + w2 * p1 + w3 * y;
                            p3 = p2; p2 = p1; p1 = y;
                        }
                    __builtin_amdgcn_sched_barrier(0);
                }
        } else {
            OUT = GATE; colbase = 256 * (u.pn - 4) + 32 * wc + 8 * fq;
        }
#pragma unroll
        for (int ai = 0; ai < 2; ++ai)
#pragma unroll
            for (int m = 0; m < 4; ++m) {
                const int jj = ai * 4 + m;
                if ((s == 0 || fr * 8 + jj >= 3) && (tl0 + jj < SEQ)) {
#pragma unroll
                    for (int bj = 0; bj < 2; ++bj) {
                        f32x4 a0 = acc[ai][bj][m][0], a1 = acc[ai][bj][m][1];
                        if (u.pn >= 4) {
                            a0 = gelu_mul4(a0, (f32x4){1.f, 1.f, 1.f, 1.f}); a1 = gelu_mul4(a1, (f32x4){1.f, 1.f, 1.f, 1.f});
                        }
                        u32x4 w; w.x = pk2(a0[0], a0[1]); w.y = pk2(a0[2], a0[3]); w.z = pk2(a1[0], a1[1]); w.w = pk2(a1[2], a1[3]);
                        *(u32x4*)(OUT + (size_t)(rowbase + jj) * 1024 + colbase + 128 * bj) = w;
                    }
                }
            }
    }
};

struct EpiGate {
    static constexpr bool PEEL = false;
    static constexpr bool RT_KSTEP = false;
    const bf16_t* XC; bf16_t* HLOC; bf16_t* PCUM; float* CEP; float* CEH; const float* gab; const float* gxb; const float* lam;
    __device__ __forceinline__ void prefetch(LAS unsigned char* prm, const Unit& u, int wid) const {
        if (wid < 6) { int t_ = threadIdx.x; asm volatile("" : "+v"(t_));
            const int c = t_ & 127, chb = 256 * (u.pn >> 1) + 128 * (u.pn & 1);
            if (wid < 2)      __builtin_amdgcn_global_load_lds((const unsigned*)(gab + chb + c), (LAS unsigned*)(prm + wid * 256), 4, 0, 0);
            else if (wid < 4) __builtin_amdgcn_global_load_lds((const unsigned*)(gxb + chb + c), (LAS unsigned*)(prm + wid * 256), 4, 0, 0);
            else              __builtin_amdgcn_global_load_lds((const unsigned*)(lam + chb + c), (LAS unsigned*)(prm + wid * 256), 4, 0, 0); }
    }
    __device__ __forceinline__ void operator()(Acc& acc, const Unit& u, int wr, int wc, int fr, int fq, LAS unsigned char* prm) const {
        { int t_ = threadIdx.x; asm volatile("" : "+v"(t_)); fr = t_ & 15; fq = (t_ >> 4) & 3; }
        const int sg = 2 * u.pm + wr;
        const int rowbase = sg * 128 + fr * 8;
        const int ch0 = 256 * (u.pn >> 1) + 128 * (u.pn & 1) + 32 * wc + 8 * fq;
        u32x2 xwv[2][8];
#pragma unroll
        for (int n = 0; n < 2; ++n)
#pragma unroll
            for (int jj = 0; jj < 8; ++jj) xwv[n][jj] = *(const u32x2*)(XC + (size_t)(rowbase + jj) * 1024 + ch0 + 4 * n);
#pragma unroll
        for (int n = 0; n < 2; ++n) {
            const int ch = ch0 + 4 * n;
            const LAS float* pp = (const LAS float*)prm + 32 * wc + 8 * fq + 4 * n;
            const f32x4 ba = *(const LAS f32x4*)(pp) * (-LOG2E), bx = *(const LAS f32x4*)(pp + 128) * (-LOG2E), lm = *(const LAS f32x4*)(pp + 256);
            f32x4 L2;
#pragma unroll
            for (int e = 0; e < 4; ++e) { const float x = lm[e]; L2[e] = (8.0f * LOG2E) * (fminf(x, 0.f) - __logf(1.0f + __expf(-fabsf(x)))); }
            f32x4 P = (f32x4){1.f, 1.f, 1.f, 1.f}, H = (f32x4){0.f, 0.f, 0.f, 0.f};
#pragma unroll
            for (int ai = 0; ai < 2; ++ai)
#pragma unroll
                for (int m = 0; m < 4; ++m) {
                    const int jj = ai * 4 + m;
                    const u32x2 xw = xwv[n][jj];
                    const f32x4 xc = (f32x4){bflo(xw.x), bfhi(xw.x), bflo(xw.y), bfhi(xw.y)};
                    const f32x4 tr = acc[ai][0][m][n] * (-LOG2E) + ba, tx = acc[ai][1][m][n] * (-LOG2E) + bx;
                    f32x4 er, ex;
#pragma unroll
                    for (int e = 0; e < 4; ++e) { er[e] = __builtin_amdgcn_exp2f(fminf(tr[e], 60.f)); ex[e] = __builtin_amdgcn_exp2f(fminf(tx[e], 60.f)); }
                    const f32x4 dr = er + 1.0f, dx = ex + 1.0f, dd = dr * dx;
                    f32x4 q;
#pragma unroll
                    for (int e = 0; e < 4; ++e) q[e] = __builtin_amdgcn_rcpf(dd[e]);
                    const f32x4 r = q * dx, ig = q * dr, la2 = L2 * r;
                    f32x4 av, mu;
#pragma unroll
                    for (int e = 0; e < 4; ++e) av[e] = __builtin_amdgcn_exp2f(la2[e]);
                    const f32x4 om = av * av * (-1.0f) + 1.0f;
#pragma unroll
                    for (int e = 0; e < 4; ++e) mu[e] = __builtin_amdgcn_sqrtf(fmaxf(om[e], 0.f));
                    H = av * H + mu * ig * xc; P = P * av;
                    acc[ai][0][m][n] = P; acc[ai][1][m][n] = H;
                    if (m == 3) __builtin_amdgcn_sched_barrier(0);
                }
            f32x4 Pi = P, Hi = H;
#pragma unroll
            for (int d = 1; d < 16; d <<= 1) {
                const f32x4 Pp = shfl_up4(Pi, d), Hp = shfl_up4(Hi, d);
                if (fr >= d) { Hi = Pi * Hp + Hi; Pi = Pi * Pp; }
            }
            f32x4 Pe = shfl_up4(Pi, 1), He = shfl_up4(Hi, 1);
            if (fr == 0) { Pe = (f32x4){1.f, 1.f, 1.f, 1.f}; He = (f32x4){0.f, 0.f, 0.f, 0.f}; }
            if (fr == 15) { *(f32x4*)(CEP + (size_t)sg * 1024 + ch) = Pi; *(f32x4*)(CEH + (size_t)sg * 1024 + ch) = Hi; }
#pragma unroll
            for (int ai = 0; ai < 2; ++ai)
#pragma unroll
                for (int m = 0; m < 4; ++m) {
                    const f32x4 p = acc[ai][0][m][n], h = acc[ai][1][m][n];
                    acc[ai][1][m][n] = h + p * He; acc[ai][0][m][n] = p * Pe;
                }
            __builtin_amdgcn_sched_barrier(0);
        }
#pragma unroll
        for (int ai = 0; ai < 2; ++ai)
#pragma unroll
            for (int m = 0; m < 4; ++m) {
                const int jj = ai * 4 + m;
                const size_t o = (size_t)(rowbase + jj) * 1024 + ch0;
                { const f32x4 a0 = acc[ai][0][m][0], a1 = acc[ai][0][m][1]; u32x4 w; w.x = pk2(a0[0], a0[1]); w.y = pk2(a0[2], a0[3]); w.z = pk2(a1[0], a1[1]); w.w = pk2(a1[2], a1[3]); *(u32x4*)(PCUM + o) = w; }
                { const f32x4 a0 = acc[ai][1][m][0], a1 = acc[ai][1][m][1]; u32x4 w; w.x = pk2(a0[0], a0[1]); w.y = pk2(a0[2], a0[3]); w.z = pk2(a1[0], a1[1]); w.w = pk2(a1[2], a1[3]); *(u32x4*)(HLOC + o) = w; }
            }
    }
};

struct EpiRes {
    static constexpr bool PEEL = false;
    static constexpr bool RT_KSTEP = true;
    __device__ __forceinline__ void prefetch(LAS unsigned char*, const Unit&, int) const {}
    bf16_t* XB; float* P2; unsigned long long* GRAN; const float* gpost; float* out; unsigned epoch; LAS float* sm; LAS float* rs1;
    __device__ __forceinline__ void operator()(Acc& acc, const Unit& u, int wr, int wc, int fr, int fq, LAS unsigned char* prm) const {
        int tid; { int t_ = threadIdx.x; asm volatile("" : "+v"(t_)); tid = t_; fr = t_ & 15; fq = (t_ >> 4) & 3; }
        const int col0 = u.pn * 256 + wc * 32 + 8 * fq;
        u32x4 xwv[2][4][2];
#pragma unroll
        for (int ai = 0; ai < 2; ++ai)
#pragma unroll
            for (int m = 0; m < 4; ++m)
#pragma unroll
                for (int bj = 0; bj < 2; ++bj)
                    xwv[ai][m][bj] = *(const u32x4*)(XB + (size_t)(u.pm * 256 + ai * 128 + wr * 64 + m * 16 + fr) * DM + col0 + bj * 128);
        f32x4 gp[2][2];
#pragma unroll
        for (int bj = 0; bj < 2; ++bj)
#pragma unroll
            for (int n = 0; n < 2; ++n) gp[bj][n] = *(const f32x4*)(gpost + col0 + bj * 128 + 4 * n);
#pragma unroll
        for (int ai = 0; ai < 2; ++ai)
#pragma unroll
            for (int m = 0; m < 4; ++m) {
                float s = 0.f;
#pragma unroll
                for (int bj = 0; bj < 2; ++bj)
#pragma unroll
                    for (int n = 0; n < 2; ++n) { const f32x4 v = acc[ai][bj][m][n]; s += (v[0] * v[0] + v[1] * v[1]) + (v[2] * v[2] + v[3] * v[3]); }
                s += __shfl_xor(s, 16); s += __shfl_xor(s, 32);
                if (fq == 0) sm[wc * 256 + ai * 128 + wr * 64 + m * 16 + fr] = s;
            }
        asm volatile("s_waitcnt lgkmcnt(0)" ::: "memory"); __builtin_amdgcn_s_barrier(); asm volatile("" ::: "memory");
        if (tid < 256) {
            const float mine = (sm[tid] + sm[256 + tid]) + (sm[512 + tid] + sm[768 + tid]);
            unsigned long long* gbase = GRAN + (size_t)u.pm * 1024 + tid;
            __hip_atomic_store(gbase + u.pn * 256, ((unsigned long long)epoch << 32) | (unsigned long long)__float_as_uint(mine), __ATOMIC_RELAXED, __HIP_MEMORY_SCOPE_AGENT);
            float part[4];
            unsigned spins = 0;
            for (;;) {
                bool ok = true;
#pragma unroll
                for (int k = 0; k < 4; ++k) {
                    const unsigned long long x = __hip_atomic_load(gbase + k * 256, __ATOMIC_RELAXED, __HIP_MEMORY_SCOPE_AGENT);
                    part[k] = __uint_as_float((unsigned)x); ok &= ((unsigned)(x >> 32) == epoch);
                }
                if (__all(ok)) break;
                __builtin_amdgcn_s_sleep(1);
                if (++spins > (1u << 22)) break;
            }
            const float tot = (part[0] + part[1]) + (part[2] + part[3]);
            rs1[tid] = 1.0f / sqrtf(tot * (1.0f / DM) + RMS_EPS);
        }
        asm volatile("s_waitcnt lgkmcnt(0)" ::: "memory"); __builtin_amdgcn_s_barrier(); asm volatile("" ::: "memory");
#pragma unroll
        for (int ai = 0; ai < 2; ++ai)
#pragma unroll
            for (int m = 0; m < 4; ++m) {
                const int rl = ai * 128 + wr * 64 + m * 16 + fr;
                const float rs = rs1[rl];
                const size_t ro = (size_t)(u.pm * 256 + rl) * DM + col0;
                float s2 = 0.f;
#pragma unroll
                for (int bj = 0; bj < 2; ++bj) {
                    const u32x4 xw = xwv[ai][m][bj];
                    f32x4 x0, x1;
                    x0[0] = bflo(xw.x); x0[1] = bfhi(xw.x); x0[2] = bflo(xw.y); x0[3] = bfhi(xw.y);
                    x1[0] = bflo(xw.z); x1[1] = bfhi(xw.z); x1[2] = bflo(xw.w); x1[3] = bfhi(xw.w);
                    x0 += acc[ai][bj][m][0] * rs * gp[bj][0]; x1 += acc[ai][bj][m][1] * rs * gp[bj][1];
                    s2 += (x0[0] * x0[0] + x0[1] * x0[1]) + (x0[2] * x0[2] + x0[3] * x0[3]) + (x1[0] * x1[0] + x1[1] * x1[1]) + (x1[2] * x1[2] + x1[3] * x1[3]);
                    u32x4 w; w.x = pk2(x0[0], x0[1]); w.y = pk2(x0[2], x0[3]); w.z = pk2(x1[0], x1[1]); w.w = pk2(x1[2], x1[3]);
                    *(u32x4*)(XB + ro + bj * 128) = w;
                    if (out) { *(f32x4*)(out + ro + bj * 128) = x0; *(f32x4*)(out + ro + bj * 128 + 4) = x1; }
                }
                s2 += __shfl_xor(s2, 16); s2 += __shfl_xor(s2, 32);
                if (fq == 0) sm[wc * 256 + rl] = s2;
            }
        asm volatile("s_waitcnt lgkmcnt(0)" ::: "memory"); __builtin_amdgcn_s_barrier(); asm volatile("" ::: "memory");
        if (tid < 256) P2[(size_t)(u.pm * 256 + tid) * 4 + u.pn] = (sm[tid] + sm[256 + tid]) + (sm[512 + tid] + sm[768 + tid]);
    }
};

struct Params {
    const float* in[21];
    float* out;
    unsigned char* ws;
    unsigned char bucket[3 * 136];
};
constexpr size_t MiB = 1024 * 1024;
constexpr size_t WS_WQKV = 0;
constexpr size_t WS_WO   = WS_WQKV + (size_t)2 * 9216 * 1024 * 2;
constexpr size_t WS_WIN  = WS_WO + (size_t)2 * 1024 * 1024 * 2;
constexpr size_t WS_WG   = WS_WIN + (size_t)2 * 2048 * 1024 * 2;
constexpr size_t WS_WOUT = WS_WG + (size_t)2 * 4 * 512 * 256 * 2;
constexpr size_t WS_WUP  = WS_WOUT + (size_t)2 * 1024 * 1024 * 2;
constexpr size_t WS_WDN  = WS_WUP + (size_t)4 * 6144 * 1024 * 2;
constexpr size_t WS_XB   = WS_WDN + (size_t)4 * 1024 * 3072 * 2;
constexpr size_t WS_ACT  = WS_XB + 64 * MiB;
constexpr size_t WS_RSTD = WS_ACT + 256 * MiB;
constexpr size_t WS_LSE  = WS_RSTD + 128 * 1024;
constexpr size_t WS_CEP  = WS_LSE + 1 * MiB;
constexpr size_t WS_CEH  = WS_CEP + 1 * MiB;
constexpr size_t WS_BAR  = WS_CEH + 1 * MiB;
constexpr size_t WS_GRAN = WS_BAR + 16384;
constexpr size_t WS_P2   = WS_GRAN + 2 * MiB;
constexpr size_t WS_END  = WS_P2 + 512 * 1024;

constexpr int LDS_BYTES = 160 * 1024;
constexpr int MISC_OFF = STAGE_BYTES;

struct TDesc { const float* W; const float* gain; bf16_t* WT; int K, N, ldw, map, blocked; };
__device__ __forceinline__ int map_row(int map, int n) {
    if (map == 0) return n;
    if (map == 1) return 256 * (n >> 7) + (n & 127);
    if (map == 2) return 256 * (n >> 7) + 128 + (n & 127);
    const int bj = n >= 3072 ? 1 : 0, jn = n - 3072 * bj; return 256 * (jn >> 7) + 128 * bj + (jn & 127);
}
__device__ __forceinline__ void tr_load(const TDesc& d, int item, int lane, float (&v)[32]) {
    const int nblk = d.N / 32, kb = item / nblk, nb = item % nblk, k0 = 64 * kb, n0 = 32 * nb;
    const float* src = d.W + (size_t)(k0 + (lane >> 5)) * d.ldw + n0 + (lane & 31);
#pragma unroll
    for (int i = 0; i < 32; ++i) v[i] = src[(size_t)(2 * i) * d.ldw];
}
__device__ __forceinline__ void tr_store(const TDesc& d, LAS float* scr, int item, int lane, const float (&v)[32]) {
    const int nblk = d.N / 32, kb = item / nblk, nb = item % nblk, k0 = 64 * kb, n0 = 32 * nb;
    const int c = lane & 7;
    f32x4 g0 = (f32x4){1.f, 1.f, 1.f, 1.f}, g1 = g0;
    if (d.gain) { g0 = *(const f32x4*)(d.gain + k0 + 8 * c); g1 = *(const f32x4*)(d.gain + k0 + 8 * c + 4); }
#pragma unroll
    for (int i = 0; i < 32; ++i) scr[(2 * i + (lane >> 5)) * 33 + (lane & 31)] = v[i];
    asm volatile("s_waitcnt lgkmcnt(0)" ::: "memory");
#pragma unroll
    for (int j = 0; j < 4; ++j) { const int n = (lane >> 3) + 8 * j; const LAS float* s = scr + (8 * c) * 33 + n;
        u32x4 o; o.x = pk2(s[0 * 33] * g0[0], s[1 * 33] * g0[1]); o.y = pk2(s[2 * 33] * g0[2], s[3 * 33] * g0[3]); o.z = pk2(s[4 * 33] * g1[0], s[5 * 33] * g1[1]); o.w = pk2(s[6 * 33] * g1[2], s[7 * 33] * g1[3]);
        bf16_t* dst = d.blocked ? d.WT + (size_t)kb * ((size_t)d.N * 64) + (size_t)map_row(d.map, n0 + n) * 64 + 8 * c : d.WT + (size_t)map_row(d.map, n0 + n) * d.K + k0 + 8 * c;
        *(u32x4*)dst = o; }
    asm volatile("s_waitcnt lgkmcnt(0)" ::: "memory");
}
__device__ __forceinline__ int tr_desc(const Params& p, int it, TDesc& d) {
    unsigned char* ws = p.ws; int r;
    constexpr int IT_QKV = 16 * 288, IT_SQ = 16 * 32, IT_IN = 16 * 64, IT_G = 4 * 8, IT_UP = 16 * 192, IT_DN = 48 * 32;
    constexpr int C0 = 2 * IT_QKV, C1 = C0 + 2 * IT_SQ, C2 = C1 + 2 * IT_IN, C3 = C2 + 16 * IT_G, C4 = C3 + 2 * IT_SQ, C5 = C4 + 4 * IT_UP;
    if (it < C0) { const int j = it / IT_QKV; r = it - j * IT_QKV; d.W = p.in[6] + (size_t)j * 1024 * 9216; d.gain = p.in[1] + (2 * j) * 1024; d.WT = (bf16_t*)(ws + WS_WQKV) + (size_t)j * 9216 * 1024; d.K = 1024; d.N = 9216; d.ldw = 9216; d.map = 0; d.blocked = 0; }
    else if (it < C1) { const int q = it - C0, j = q / IT_SQ; r = q - j * IT_SQ; d.W = p.in[7] + (size_t)j * 1024 * 1024; d.gain = nullptr; d.WT = (bf16_t*)(ws + WS_WO) + (size_t)j * 1024 * 1024; d.K = 1024; d.N = 1024; d.ldw = 1024; d.map = 0; d.blocked = 0; }
    else if (it < C2) { const int q = it - C1, j = q / IT_IN; r = q - j * IT_IN; d.W = p.in[8] + (size_t)j * 1024 * 2048; d.gain = p.in[1] + (2 * j + 1) * 1024; d.WT = (bf16_t*)(ws + WS_WIN) + (size_t)j * 2048 * 1024; d.K = 1024; d.N = 2048; d.ldw = 2048; d.map = 0; d.blocked = 0; }
    else if (it < C3) { const int q = it - C2, mi = q / IT_G; r = q - mi * IT_G; const int which = mi >> 3, jn = mi & 7;
        d.W = (which ? p.in[13] : p.in[11]) + (size_t)jn * 65536; d.gain = nullptr; d.WT = (bf16_t*)(ws + WS_WG) + (size_t)jn * 512 * 256; d.K = 256; d.N = 256; d.ldw = 256; d.map = 1 + which; d.blocked = 0; }
    else if (it < C4) { const int q = it - C3, j = q / IT_SQ; r = q - j * IT_SQ; d.W = p.in[16] + (size_t)j * 1024 * 1024; d.gain = nullptr; d.WT = (bf16_t*)(ws + WS_WOUT) + (size_t)j * 1024 * 1024; d.K = 1024; d.N = 1024; d.ldw = 1024; d.map = 0; d.blocked = 0; }
    else if (it < C5) { const int q = it - C4, l = q / IT_UP; r = q - l * IT_UP; d.W = p.in[17] + (size_t)l * 1024 * 6144; d.gain = p.in[3] + l * 1024; d.WT = (bf16_t*)(ws + WS_WUP) + (size_t)l * 6144 * 1024; d.K = 1024; d.N = 6144; d.ldw = 6144; d.map = 3; d.blocked = 0; }
    else { const int q = it - C5, l = q / IT_DN; r = q - l * IT_DN; d.W = p.in[20] + (size_t)l * 3072 * 1024; d.gain = nullptr; d.WT = (bf16_t*)(ws + WS_WDN) + (size_t)l * 1024 * 3072; d.K = 3072; d.N = 1024; d.ldw = 1024; d.map = 0; d.blocked = 1; }
    return r;
}
__device__ __forceinline__ void prologue(const Params& p, LAS unsigned char* lds, int gw, int NGW, int wave) {
    int lane; { int t_ = threadIdx.x; asm volatile("" : "+v"(t_)); lane = t_ & 63; }
    LAS float* scr = (LAS float*)(lds + wave * 8448);
    unsigned char* ws = p.ws;
    constexpr int NITEMS = 2 * 16 * 288 + 2 * 16 * 32 + 2 * 16 * 64 + 16 * 32 + 2 * 16 * 32 + 4 * 16 * 192 + 4 * 48 * 32;
    {
        int it = gw;
        TDesc d; int r = 0; float a[32];
        if (it < NITEMS) { r = tr_desc(p, it, d); tr_load(d, r, lane, a); }
        while (it < NITEMS) {
            const int nit = it + NGW;
            TDesc dn; int rn = 0; float b[32];
            if (nit < NITEMS) { rn = tr_desc(p, nit, dn); tr_load(dn, rn, lane, b); }
            __builtin_amdgcn_sched_barrier(0);
            tr_store(d, scr, r, lane, a);
            __builtin_amdgcn_sched_barrier(0);
            if (nit < NITEMS) {
                d = dn; r = rn;
#pragma unroll
                for (int i = 0; i < 32; ++i) a[i] = b[i];
            }
            it = nit;
        }
    }
    const float* x = p.in[0]; bf16_t* XB = (bf16_t*)(ws + WS_XB); float* P2 = (float*)(ws + WS_P2);
    for (int m0 = gw * 4; m0 < M_TOK; m0 += NGW * 4) {
        f32x4 v[4][4]; float ss[4];
#pragma unroll
        for (int r = 0; r < 4; ++r) { const f32x4* xr = (const f32x4*)(x + (size_t)(m0 + r) * DM) + lane;
#pragma unroll
            for (int j = 0; j < 4; ++j) v[r][j] = xr[64 * j]; }
#pragma unroll
        for (int r = 0; r < 4; ++r) { float s = 0.f;
#pragma unroll
            for (int j = 0; j < 4; ++j) s += (v[r][j][0] * v[r][j][0] + v[r][j][1] * v[r][j][1]) + (v[r][j][2] * v[r][j][2] + v[r][j][3] * v[r][j][3]);
            ss[r] = s; }
#pragma unroll
        for (int o = 1; o < 64; o <<= 1) {
#pragma unroll
            for (int r = 0; r < 4; ++r) ss[r] += __shfl_xor(ss[r], o);
        }
#pragma unroll
        for (int r = 0; r < 4; ++r) {
            u32x2* o8 = (u32x2*)(XB + (size_t)(m0 + r) * DM) + lane;
#pragma unroll
            for (int j = 0; j < 4; ++j) { u32x2 w; w.x = pk2(v[r][j][0], v[r][j][1]); w.y = pk2(v[r][j][2], v[r][j][3]); o8[64 * j] = w; }
            if (lane == 0) *(f32x4*)(P2 + (size_t)(m0 + r) * 4) = (f32x4){ss[r], 0.f, 0.f, 0.f};
        }
    }
    { unsigned long long* G8 = (unsigned long long*)(ws + WS_GRAN); for (int i = gw * 64 + lane; i < 262144; i += NGW * 64) G8[i] = 0ull; }
}

__device__ __forceinline__ void lru_apply(const bf16_t* HLOC, const bf16_t* PCUM, const bf16_t* GATE, bf16_t* HA, const float* CEP, const float* CEH) {
    int tid_ = threadIdx.x; asm volatile("" : "+v"(tid_));
    const int tid = tid_, cgp = tid & 127, rsl = tid >> 7, ch = 8 * cgp;
    for (int sg = blockIdx.x; sg < 256; sg += gridDim.x) {
        const int b = sg >> 6, c = sg & 63;
        float carry[8];
#pragma unroll
        for (int e = 0; e < 8; ++e) carry[e] = 0.f;
        for (int k0 = 0; k0 < c; k0 += 4) {
            f32x4 pq[4][2], hq[4][2];
#pragma unroll
            for (int i = 0; i < 4; ++i) {
                const int k = (k0 + i < c) ? (k0 + i) : (c - 1);
                const size_t o = (size_t)(b * 64 + k) * 1024 + ch;
                pq[i][0] = *(const f32x4*)(CEP + o); pq[i][1] = *(const f32x4*)(CEP + o + 4); hq[i][0] = *(const f32x4*)(CEH + o); hq[i][1] = *(const f32x4*)(CEH + o + 4);
            }
            __builtin_amdgcn_sched_barrier(0);
#pragma unroll
            for (int i = 0; i < 4; ++i) {
                if (k0 + i < c) {
#pragma unroll
                    for (int e = 0; e < 4; ++e) { carry[e] = pq[i][0][e] * carry[e] + hq[i][0][e]; carry[4 + e] = pq[i][1][e] * carry[4 + e] + hq[i][1][e]; }
                }
            }
        }
        for (int r0 = 0; r0 < 32; r0 += 4) {
            u32x4 hl[4], pc[4], gt[4];
#pragma unroll
            for (int i = 0; i < 4; ++i) {
                const size_t o = (size_t)(sg * 128 + rsl * 32 + r0 + i) * 1024 + ch;
                hl[i] = *(const u32x4*)(HLOC + o); pc[i] = *(const u32x4*)(PCUM + o); gt[i] = *(const u32x4*)(GATE + o);
            }
            __builtin_amdgcn_sched_barrier(0);
#pragma unroll
            for (int i = 0; i < 4; ++i) {
                const size_t o = (size_t)(sg * 128 + rsl * 32 + r0 + i) * 1024 + ch;
                u32x4 w;
#pragma unroll
                for (int q = 0; q < 4; ++q) {
                    const float v0 = (bflo(hl[i][q]) + bflo(pc[i][q]) * carry[2 * q]) * bflo(gt[i][q]);
                    const float v1 = (bfhi(hl[i][q]) + bfhi(pc[i][q]) * carry[2 * q + 1]) * bfhi(gt[i][q]);
                    w[q] = pk2(v0, v1);
                }
                *(u32x4*)(HA + o) = w;
            }
        }
    }
}

__device__ __forceinline__ unsigned off_b(unsigned row, unsigned ch) { return 256u * row + 16u * (ch ^ (((row & 3) << 2) | ((row >> 2) & 3))); }
__device__ __forceinline__ unsigned tr_addr16(unsigned lane, unsigned c, unsigned ks, unsigned t) {
    const unsigned g = lane >> 4, q = (lane & 15) >> 2, pp = lane & 3;
    return off_b(32 * ks + 8 * g + 4 * t + q, 2 * c + (pp >> 1)) + 8 * (pp & 1);
}
__device__ __forceinline__ void attn_phase(const Params& p, LAS unsigned char* lds, const bf16_t* QKV, bf16_t* OB, float* LSE, int g) {
    int tid_ = threadIdx.x; asm volatile("" : "+v"(tid_));
    const int tid = tid_, lane = tid & 63, w = __builtin_amdgcn_readfirstlane(tid >> 6), fr = lane & 15, fq = lane >> 4;
    const int dshift = 2 * g, csb = 4 - 2 * g;
    LAS float* bt = (LAS float*)(lds + MISC_OFF + 26624);
    const float* rel_bias = p.in[5];
    const float sc2 = 0.08838834764831845f * LOG2E;
    for (int ck = blockIdx.x; ck < 512; ck += gridDim.x) {
        const int idx16 = ck & 15, bh = ck >> 4, b = bh >> 3, h = bh & 7;
        const int x = idx16 >> csb, cseq = idx16 & ((1 << csb) - 1), n_start = 4 * cseq;
        const size_t tokbase = (size_t)b * SEQ + x;
        for (int e = tid; e < 1024; e += 512) {
            const int r = e >> 8, idx = e & 255, m = 160 + r - idx;
            const int mc = m < 0 ? 0 : (m > 128 ? 128 : m);
            const float bv = rel_bias[(int)p.bucket[g * 136 + mc] * 24 + g * 8 + h] * LOG2E;
            bt[e] = (m >= 0 && m <= 128) ? bv : -1e30f;
        }
        u32x4 pre[8];
#pragma unroll
        for (int i = 0; i < 4; ++i) {
            const int c = tid + 512 * i, row = c >> 4, chn = c & 15;
            if (n_start > 0) {
                const size_t tk = tokbase + ((size_t)((n_start - 1) * 128 + row) << dshift);
                const bf16_t* src = QKV + ((size_t)(8 + h) * M_TOK + tk) * 128 + chn * 8;
                pre[i] = *(const u32x4*)src; pre[4 + i] = *(const u32x4*)(src + (size_t)8 * M_TOK * 128);
            } else { pre[i] = (u32x4){0u, 0u, 0u, 0u}; pre[4 + i] = pre[i]; }
        }
#pragma unroll
        for (int i = 0; i < 4; ++i) { const int c = tid + 512 * i, row = c >> 4, chn = c & 15; const unsigned o = off_b(row, chn);
            *(LAS u32x4*)(lds + 65536 + o) = pre[i]; *(LAS u32x4*)(lds + 65536 + 32768 + o) = pre[4 + i]; }
#pragma unroll
        for (int i = 0; i < 4; ++i) {
            const int c = tid + 512 * i, row = c >> 4, chn = c & 15;
            const size_t tk = tokbase + ((size_t)(n_start * 128 + row) << dshift);
            const bf16_t* src = QKV + ((size_t)(8 + h) * M_TOK + tk) * 128 + chn * 8;
            pre[i] = *(const u32x4*)src; pre[4 + i] = *(const u32x4*)(src + (size_t)8 * M_TOK * 128);
        }
#pragma unroll
        for (int i = 0; i < 4; ++i) { const int c = tid + 512 * i, row = c >> 4, chn = c & 15; const unsigned o = off_b(row, chn);
            *(LAS u32x4*)(lds + o) = pre[i]; *(LAS u32x4*)(lds + 32768 + o) = pre[4 + i]; }
        __syncthreads();
        bf16x8 qf[4];
        { const size_t rq0 = tokbase + ((size_t)(n_start * 128 + 16 * w + fr) << dshift);
#pragma unroll
          for (int s = 0; s < 4; ++s) qf[s] = *(const bf16x8*)(QKV + ((size_t)h * M_TOK + rq0) * 128 + 32 * s + 8 * fq); }
        for (int bi = 0; bi < 4; ++bi) {
            const int n = n_start + bi;
            const unsigned cur = (unsigned)(bi & 1) * 65536u, prv = cur ^ 65536u;
            if (bi < 3) {
#pragma unroll
                for (int i = 0; i < 4; ++i) {
                    const int c = tid + 512 * i, row = c >> 4, chn = c & 15;
                    const size_t tk = tokbase + ((size_t)((n + 1) * 128 + row) << dshift);
                    const bf16_t* src = QKV + ((size_t)(8 + h) * M_TOK + tk) * 128 + chn * 8;
                    pre[i] = *(const u32x4*)src; pre[4 + i] = *(const u32x4*)(src + (size_t)8 * M_TOK * 128);
                }
            }
            __builtin_amdgcn_sched_barrier(0);
            int ln_ = lane; asm volatile("" : "+v"(ln_));
            const int fr = ln_ & 15, fq = ln_ >> 4;
            const int iq = 16 * w + fr;
            const size_t rowq = tokbase + ((size_t)(n * 128 + iq) << dshift);
            const int kb0 = w >> 1;
            const LAS float* tb = bt + (fr & 3) * 256 + (160 - (iq + 128 - 32 * kb0 - 8 * fq) + (fr & 3));
            f32x4 sacc[5][2];
            float mx = -1e30f;
            bf16x8 kf[2][4]; f32x4 bvv[2], bvn[2];
#define ATT_LOADK(kk_) do { const int kb_ = kb0 + (kk_); const unsigned slot_ = (kb_ >> 2) ? cur : prv; const int ksub_ = kb_ & 3; \
                _Pragma("unroll") for (int T = 0; T < 2; ++T) { const unsigned kr_ = 32 * ksub_ + 8 * (fr >> 2) + 4 * T + (fr & 3); \
                    _Pragma("unroll") for (int s = 0; s < 4; ++s) kf[T][s] = *(const LAS bf16x8*)(lds + slot_ + off_b(kr_, 4 * s + fq)); } \
                bvn[0] = *(const LAS f32x4*)(tb + 32 * (kk_)); bvn[1] = *(const LAS f32x4*)(tb + 32 * (kk_) + 4); } while (0)
            ATT_LOADK(0);
#pragma unroll
            for (int kk = 0; kk < 5; ++kk) {
                const int kb = kb0 + kk;
                __builtin_amdgcn_sched_barrier(0);
                f32x4 a0 = (f32x4){0.f, 0.f, 0.f, 0.f}, a1 = a0;
#pragma unroll
                for (int s = 0; s < 4; ++s) {
                    a0 = __builtin_amdgcn_mfma_f32_16x16x32_bf16(kf[0][s], qf[s], a0, 0, 0, 0);
                    a1 = __builtin_amdgcn_mfma_f32_16x16x32_bf16(kf[1][s], qf[s], a1, 0, 0, 0);
                }
                bvv[0] = bvn[0]; bvv[1] = bvn[1];
                __builtin_amdgcn_sched_barrier(0);
                if (kk < 4) ATT_LOADK(kk + 1);
                __builtin_amdgcn_sched_barrier(0);
                const bool dead = (n == 0) && (kb < 4);
#pragma unroll
                for (int j = 0; j < 4; ++j) {
                    const float l0 = dead ? -1e30f : a0[j] * sc2 + bvv[0][j];
                    const float l1 = dead ? -1e30f : a1[j] * sc2 + bvv[1][j];
                    a0[j] = l0; a1[j] = l1; mx = fmaxf(mx, fmaxf(l0, l1));
                }
                sacc[kk][0] = a0; sacc[kk][1] = a1;
            }
#undef ATT_LOADK
            mx = fmaxf(mx, __shfl_xor(mx, 16)); mx = fmaxf(mx, __shfl_xor(mx, 32));
            float psum = 0.f;
            bf16x8 pf[5];
#pragma unroll
            for (int kk = 0; kk < 5; ++kk) {
                float pv[8];
#pragma unroll
                for (int T = 0; T < 2; ++T)
#pragma unroll
                    for (int j = 0; j < 4; ++j) { const float e = __builtin_amdgcn_exp2f(sacc[kk][T][j] - mx); pv[4 * T + j] = e; psum += e; }
                u32x4 pw; pw.x = pk2(pv[0], pv[1]); pw.y = pk2(pv[2], pv[3]); pw.z = pk2(pv[4], pv[5]); pw.w = pk2(pv[6], pv[7]);
                pf[kk] = __builtin_bit_cast(bf16x8, pw);
            }
            psum += __shfl_xor(psum, 16); psum += __shfl_xor(psum, 32);
            __builtin_amdgcn_sched_barrier(0);
            if (bi < 3) {
                const size_t rqn = tokbase + ((size_t)((n + 1) * 128 + iq) << dshift);
#pragma unroll
                for (int s = 0; s < 4; ++s) qf[s] = *(const bf16x8*)(QKV + ((size_t)h * M_TOK + rqn) * 128 + 32 * s + 8 * fq);
            }
            bf16_t* orow = OB + ((size_t)(2 * h) * M_TOK + rowq) * 64 + 4 * fq;
            u32x2 oprev[8]; float lp = 0.f;
            if (g > 0) {
                lp = LSE[rowq * 8 + h];
#pragma unroll
                for (int c = 0; c < 8; ++c) oprev[c] = *(const u32x2*)(orow + (size_t)(c >> 2) * M_TOK * 64 + 16 * (c & 3));
            }
            __builtin_amdgcn_sched_barrier(0);
            f32x4 oacc[8];
#pragma unroll
            for (int c = 0; c < 8; ++c) oacc[c] = (f32x4){0.f, 0.f, 0.f, 0.f};
#pragma unroll
            for (int kk = 0; kk < 5; ++kk) {
                const int kb = kb0 + kk; const unsigned slot = ((kb >> 2) ? cur : prv) + 32768u; const int ksub = kb & 3;
                bf16x4 vlo[8], vhi[8];
#pragma unroll
                for (int c = 0; c < 8; ++c) {
                    vlo[c] = __builtin_amdgcn_ds_read_tr16_b64_v4i16((LAS bf16x4*)(lds + slot + tr_addr16(lane, c, ksub, 0)));
                    vhi[c] = __builtin_amdgcn_ds_read_tr16_b64_v4i16((LAS bf16x4*)(lds + slot + tr_addr16(lane, c, ksub, 1)));
                }
                __builtin_amdgcn_sched_barrier(0);
#pragma unroll
                for (int c = 0; c < 8; ++c) {
                    bf16x8 vf; vf[0] = vlo[c][0]; vf[1] = vlo[c][1]; vf[2] = vlo[c][2]; vf[3] = vlo[c][3]; vf[4] = vhi[c][0]; vf[5] = vhi[c][1]; vf[6] = vhi[c][2]; vf[7] = vhi[c][3];
                    oacc[c] = __builtin_amdgcn_mfma_f32_16x16x32_bf16(vf, pf[kk], oacc[c], 0, 0, 0);
                }
                __builtin_amdgcn_sched_barrier(0);
            }
            const float inv = __builtin_amdgcn_rcpf(psum);
            float lse2 = mx + __builtin_amdgcn_logf(psum);
            float wc_ = inv, wp_ = 0.f;
            if (g > 0) {
                const float mN = fmaxf(lp, lse2);
                const float ep = __builtin_amdgcn_exp2f(lp - mN), ec = __builtin_amdgcn_exp2f(lse2 - mN);
                const float den = ep + ec, rden = __builtin_amdgcn_rcpf(den);
                wp_ = ep * rden; wc_ = ec * rden * inv;
                lse2 = mN + __builtin_amdgcn_logf(den);
            }
#pragma unroll
            for (int c = 0; c < 8; ++c) {
                f32x4 o = oacc[c] * wc_;
                if (g > 0) { const u32x2 pw = oprev[c]; o[0] += wp_ * bflo(pw.x); o[1] += wp_ * bfhi(pw.x); o[2] += wp_ * bflo(pw.y); o[3] += wp_ * bfhi(pw.y); }
                u32x2 ow; ow.x = pk2(o[0], o[1]); ow.y = pk2(o[2], o[3]);
                *(u32x2*)(orow + (size_t)(c >> 2) * M_TOK * 64 + 16 * (c & 3)) = ow;
            }
            if (g < 2 && fq == 0) LSE[rowq * 8 + h] = lse2;
            __syncthreads();
            if (bi < 3) {
#pragma unroll
                for (int i = 0; i < 4; ++i) { const int c = tid + 512 * i, row = c >> 4, chn = c & 15; const unsigned o = off_b(row, chn);
                    *(LAS u32x4*)(lds + prv + o) = pre[i]; *(LAS u32x4*)(lds + prv + 32768 + o) = pre[4 + i]; }
            }
            __syncthreads();
        }
    }
}


#define XB_TMO      128
#define XB_XCNT(j)  (256  + 64 * (j))
#define XB_XSUB(j)  (1280 + 64 * (j))
#define XB_XGEN(j)  (2304 + 64 * (j))
#define XB_TOP      3328
#define XB_TOPGEN   3392
#define XCD_BAR_WORDS 3456
#define XB_SPIN_CAP (1u << 22)
__device__ __forceinline__ unsigned xb_ld(unsigned* p)              { return __hip_atomic_load(p, __ATOMIC_RELAXED, __HIP_MEMORY_SCOPE_AGENT); }
__device__ __forceinline__ unsigned xb_add(unsigned* p, unsigned v) { return __hip_atomic_fetch_add(p, v, __ATOMIC_RELAXED, __HIP_MEMORY_SCOPE_AGENT); }
__device__ __forceinline__ unsigned xb_xcc_id() { return (unsigned)__builtin_amdgcn_s_getreg((3 << 11) | 20) & 0xFu; }
#define XB_SPIN(cond, bar) do { unsigned _sp = 0; while (cond) { __builtin_amdgcn_s_sleep(1); \
    if ((++_sp & 255u) == 0u) { if (xb_ld(&(bar)[XB_TMO])) break; if (_sp > XB_SPIN_CAP) { atomicAdd(&(bar)[XB_TMO], 1u); break; } } } } while (0)
struct XcdBarrier { unsigned* bar; unsigned x; volatile LAS unsigned* st; };
__device__ __forceinline__ XcdBarrier xcd_barrier_post(unsigned* bar, volatile LAS unsigned* st) {
    XcdBarrier b; b.bar = bar; b.x = xb_xcc_id(); b.st = st;
    if (threadIdx.x == 0) (void)xb_add(&bar[XB_XCNT(b.x)], 1u);
    return b;
}
__device__ __forceinline__ void xcd_barrier_complete(unsigned* bar, unsigned x, unsigned& nloc, unsigned& nx) {
    const unsigned G = gridDim.x * gridDim.y * gridDim.z;
    unsigned sum, cnt, mine, sp = 0u;
    for (;;) {
        sum = 0u; cnt = 0u; mine = 0u;
#pragma unroll
        for (unsigned j = 0; j < 16; ++j) { const unsigned c = xb_ld(&bar[XB_XCNT(j)]); sum += c; cnt += (c > 0u) ? 1u : 0u; mine = (j == x) ? c : mine; }
        if (sum == G) break;
        __builtin_amdgcn_s_sleep(1);
        if ((++sp & 255u) == 0u) { if (xb_ld(&bar[XB_TMO])) break; if (sp > XB_SPIN_CAP) { atomicAdd(&bar[XB_TMO], 1u); break; } }
    }
    nloc = mine > 0u ? mine : 1u; nx = cnt > 0u ? cnt : 1u;
}
__device__ __forceinline__ void xcd_barrier(const XcdBarrier& b) {
    asm volatile("s_waitcnt vmcnt(0)" ::: "memory");
    __syncthreads();
    if (threadIdx.x == 0) {
        unsigned* bar = b.bar;
        __builtin_amdgcn_s_waitcnt(0);
        unsigned nloc = b.st[0], nx = b.st[1];
        if (nloc == 0u) { xcd_barrier_complete(bar, b.x, nloc, nx); b.st[0] = nloc; b.st[1] = nx; }
        const unsigned old = xb_add(&bar[XB_XSUB(b.x)], 1u);
        const unsigned gen = old / nloc;
        if (old + 1u == (gen + 1u) * nloc) {
            __builtin_amdgcn_fence(__ATOMIC_RELEASE, "agent");
            asm volatile("s_waitcnt vmcnt(0)" ::: "memory");
            const unsigned og = xb_add(&bar[XB_TOP], 1u);
            const unsigned tg = og / nx;
            if (og + 1u == (tg + 1u) * nx) xb_add(&bar[XB_TOPGEN], 1u);
            else XB_SPIN(xb_ld(&bar[XB_TOPGEN]) == tg, bar);
            __builtin_amdgcn_fence(__ATOMIC_ACQUIRE, "agent");
            xb_add(&bar[XB_XGEN(b.x)], 1u);
            asm volatile("s_waitcnt vmcnt(0)" ::: "memory");
        } else {
            XB_SPIN(xb_ld(&bar[XB_XGEN(b.x)]) == gen, bar);
            __builtin_amdgcn_fence(__ATOMIC_ACQUIRE, "agent");
            asm volatile("s_waitcnt vmcnt(0)" ::: "memory");
        }
    }
    __syncthreads();
}

__global__ void __launch_bounds__(512, 2) fwd_megakernel(Params p) {
    extern __shared__ __attribute__((aligned(16))) unsigned char lds_raw[];
    LAS unsigned char* lds = (LAS unsigned char*)lds_raw;
    cg::grid_group grid = cg::this_grid();
    const int wave = __builtin_amdgcn_readfirstlane((int)threadIdx.x >> 6);
    const int G = gridDim.x, gw = blockIdx.x * 8 + wave, NGW = G * 8;
    unsigned char* ws0 = p.ws;
    StaticOrder S;
    volatile LAS unsigned* bst = (volatile LAS unsigned*)(lds + MISC_OFF + 2048);
    if (threadIdx.x < 4) bst[threadIdx.x] = 0u;
    __syncthreads();
    const XcdBarrier xbar = xcd_barrier_post((unsigned*)(ws0 + WS_BAR), bst);

    prologue(p, lds, gw, NGW, wave);
    grid.sync();

    for (int layer = 0; layer < 4; ++layer) {
        const int j = layer >> 1;
        const bool even = (layer & 1) == 0;
        const int nst = even ? 9 : 6;
        for (int si = 0; si < nst; ++si) {
            const int code = even ? si : (si < 3 ? 9 + si : si + 3);
            unsigned char* ws = ws0; asm volatile("" : "+s"(ws));
            bf16_t* XB = (bf16_t*)(ws + WS_XB); float* P2 = (float*)(ws + WS_P2); float* LSE = (float*)(ws + WS_LSE);
            float* CEP = (float*)(ws + WS_CEP); float* CEH = (float*)(ws + WS_CEH);
            bf16_t* ACT0 = (bf16_t*)(ws + WS_ACT); bf16_t* ACT1 = (bf16_t*)(ws + WS_ACT + 64 * MiB); bf16_t* ACT2 = (bf16_t*)(ws + WS_ACT + 128 * MiB); bf16_t* ACT3 = (bf16_t*)(ws + WS_ACT + 192 * MiB);
            if (code == 0 || code == 2 || code == 4) {
                const int g = code >> 1;
                Gemm gm{XB, (const bf16_t*)(ws + WS_WQKV) + ((size_t)j * 9216 + (size_t)g * 3072) * 1024, 1024, 1024, 1024, 128, 12, 0, 0, 1, 128, 128};
                S.init(128, 12, G, blockIdx.x);
                EpiScale E{ACT0, 3072, P2};
                gemm_phase<EpiScale>(lds, gm, S, E);
            } else if (code == 1 || code == 3 || code == 5) {
                attn_phase(p, lds, ACT0, ACT3, LSE, code >> 1);
            } else if (code == 6 || code == 8) {
                Gemm gm;
                if (code == 6) {
                    if (even) gm = Gemm{ACT3, (const bf16_t*)(ws + WS_WO) + (size_t)j * 1024 * 1024, 64, 1024, 1024, 128, 4, 0, 0, 1, M_TOK * 128, 128};
                    else      gm = Gemm{ACT0, (const bf16_t*)(ws + WS_WOUT) + (size_t)j * 1024 * 1024, 1024, 1024, 1024, 128, 4, 0, 0, 1, 128, 128};
                } else        gm = Gemm{ACT0, (const bf16_t*)(ws + WS_WDN) + (size_t)layer * 1024 * 3072, 64, 64, 3072, 128, 4, 0, 0, 1, M_TOK * 128, 1024 * 128};
                S.init(128, 4, G, blockIdx.x);
                EpiRes E{XB, P2, (unsigned long long*)(ws + WS_GRAN), (code == 6 ? p.in[2] : p.in[4]) + layer * 1024, (layer == 3 && code == 8) ? p.out : nullptr,
                         (unsigned)(layer * 2 + (code == 8 ? 1 : 0) + 1), (LAS float*)(lds + MISC_OFF + 4096), (LAS float*)(lds + MISC_OFF + 8192)};
                gemm_phase<EpiRes>(lds, gm, S, E);
            } else if (code == 7) {
                Gemm gm{XB, (const bf16_t*)(ws + WS_WUP) + (size_t)layer * 6144 * 1024, 1024, 1024, 1024, 130, 24, 1, 126, 65, 128, 128};
                S.init(130, 24, G, blockIdx.x);
                EpiUp E{ACT0, P2, p.in[18] + (size_t)layer * 3 * 6144, p.in[19] + (size_t)layer * 6144};
                gemm_phase<EpiUp>(lds, gm, S, E);
            } else if (code == 9) {
                Gemm gm{XB, (const bf16_t*)(ws + WS_WIN) + (size_t)j * 2048 * 1024, 1024, 1024, 1024, 132, 8, 1, 125, 66, 128, 128};
                S.init(132, 8, G, blockIdx.x);
                EpiIn E{ACT0, ACT1, P2, p.in[9] + (size_t)j * 4 * 1024, p.in[10] + (size_t)j * 1024};
                gemm_phase<EpiIn>(lds, gm, S, E);
            } else if (code == 10) {
                Gemm gm{ACT0, (const bf16_t*)(ws + WS_WG) + (size_t)j * 4 * 512 * 256, 1024, 256, 256, 128, 8, 2, 128, 64, 128, 128};
                S.init(128, 8, G, blockIdx.x);
                EpiGate E{ACT0, ACT2, ACT3, CEP, CEH, p.in[12] + (size_t)j * 1024, p.in[14] + (size_t)j * 1024, p.in[15] + (size_t)j * 1024};
                gemm_phase<EpiGate>(lds, gm, S, E);
            } else {
                lru_apply(ACT2, ACT3, ACT1, ACT0, CEP, CEH);
            }
            if (!(layer == 3 && si == nst - 1)) xcd_barrier(xbar);
        }
    }
}

static int t5_bucket_host(int dist) {
    const int max_exact = 16;
    if (dist < max_exact) return dist;
    const double d = (double)(dist < 1 ? 1 : dist);
    int large = max_exact + (int)(std::log(d / max_exact) / std::log(2048.0 / max_exact) * (32 - max_exact));
    return large < 31 ? large : 31;
}

extern "C" void kernel_launch(void* const* d_in, const int* in_sizes, int n_in, void* d_out, int out_size, void* d_ws, size_t ws_size, hipStream_t stream) {
    if (n_in != 21 || out_size != M_TOK * DM || ws_size < WS_END) { fprintf(stderr, "kernel_launch: unexpected shapes (n_in %d out %d ws %zu need %zu)\n", n_in, out_size, ws_size, (size_t)WS_END); return; }
    static int grid_blocks = 0;
    if (!grid_blocks) {
        int dev = 0, cus = 0, per_cu = 0;
        hipGetDevice(&dev);
        hipDeviceGetAttribute(&cus, hipDeviceAttributeMultiprocessorCount, dev);
        hipFuncSetAttribute((const void*)fwd_megakernel, hipFuncAttributeMaxDynamicSharedMemorySize, LDS_BYTES);
        hipOccupancyMaxActiveBlocksPerMultiprocessor(&per_cu, (const void*)fwd_megakernel, 512, LDS_BYTES);
        if (per_cu < 1) per_cu = 1;
        grid_blocks = cus * per_cu;
        if (grid_blocks > 256) grid_blocks = 256;
    }
    if (grid_blocks != 256) { fprintf(stderr, "kernel_launch: needs a 256-workgroup cooperative grid (got %d)\n", grid_blocks); return; }
    Params p; memset(&p, 0, sizeof(p));
    for (int i = 0; i < 21; ++i) p.in[i] = (const float*)d_in[i];
    p.out = (float*)d_out; p.ws = (unsigned char*)d_ws;
    const int dil[3] = {1, 4, 16};
    for (int g = 0; g < 3; ++g) for (int m = 0; m <= 128; ++m) p.bucket[g * 136 + m] = (unsigned char)t5_bucket_host(m * dil[g]);
    (void)hipMemsetAsync((unsigned char*)d_ws + WS_BAR, 0, 16384, stream);
    void* args[] = {&p};
    hipError_t e = hipLaunchCooperativeKernel((const void*)fwd_megakernel, dim3(grid_blocks), dim3(512), args, LDS_BYTES, stream);
    if (e != hipSuccess) fprintf(stderr, "cooperative launch failed: %s (grid %d)\n", hipGetErrorString(e), grid_blocks);
}
```
